# Optimizing an MI355X kernel written in HIP

```python
import math
import jax
import jax.numpy as jnp
from jax import lax
import numpy as np

D_MODEL = 1024
BATCH = 16
SEQ = 2048
DEPTH = 2
DEC_BATCH = 32
DEC_SEQ = 32
PAST_LEN = 1024

CHUNK = 64
REC_BLOCK = CHUNK // 4
HG_HEADS = 4
HG_DK = 128
HG_DV = 128
GDN_HEADS = 4
GDN_DK = 128
GDN_DV = 128
CONV_W = 4
D_FF = -(-(8 * D_MODEL) // (3 * 256)) * 256
N_MOD = 6
EPS = 1e-6
HG_QK = HG_HEADS * HG_DK
HG_V = HG_HEADS * HG_DV
GDN_QK = GDN_HEADS * GDN_DK
GDN_V = GDN_HEADS * GDN_DV
CONV_CH = 2 * GDN_QK + GDN_V
IN_SIZES = (HG_QK, HG_QK, HG_V, HG_V, GDN_QK, GDN_QK, GDN_V, GDN_HEADS, GDN_HEADS, GDN_V, D_MODEL, D_MODEL)
D_IN = 2 * HG_QK + 2 * HG_V + 2 * GDN_QK + 2 * GDN_V + 2 * GDN_HEADS + 2 * D_MODEL

kernel_name = "hybrid_hgrn2_gdn_streaming_step"


def rmsnorm(x, w):
    xf = x.astype(jnp.float32)
    y = xf * lax.rsqrt(jnp.mean(jnp.square(xf), axis=-1, keepdims=True) + EPS)
    return (y * w.astype(jnp.float32)).astype(x.dtype)


def l2norm(x):
    xf = x.astype(jnp.float32)
    return xf * lax.rsqrt(jnp.sum(jnp.square(xf), axis=-1, keepdims=True) + EPS)


def split_cols(a, sizes):
    out, start = [], 0
    for s in sizes:
        out.append(a[..., start:start + s])
        start += s
    return out


def to_blocks(a, n_blocks):
    B, T = a.shape[:2]
    pad = [(0, 0), (0, n_blocks * REC_BLOCK - T)] + [(0, 0)] * (a.ndim - 2)
    a = jnp.pad(a, pad).reshape((B, n_blocks, REC_BLOCK) + a.shape[2:])
    return jnp.moveaxis(a, (1, 3), (0, 2))


def from_blocks(o, T):
    n, B, H, L, d = o.shape
    return o.transpose(1, 0, 3, 2, 4).reshape(B, n * L, H, d)[:, :T]


def chunk_gla(q, k, v, log_f, s0):
    T = q.shape[1]
    n = -(-T // REC_BLOCK)
    incl = jnp.tril(jnp.ones((REC_BLOCK, REC_BLOCK), dtype=bool))
    blocks = tuple(to_blocks(a.astype(jnp.float32), n) for a in (q, k, v, log_f))

    def step(S, blk):
        qc, kc, vc, gc = blk
        G = jnp.cumsum(gc, axis=2)
        rel = jnp.exp(jnp.where(incl[:, :, None], G[:, :, :, None, :] - G[:, :, None, :, :], -jnp.inf))
        A = jnp.einsum("bhtd,bhsd,bhtsd->bhts", qc, kc, rel)
        o = jnp.einsum("bhtd,bhdv->bhtv", qc * jnp.exp(G), S) + jnp.einsum("bhts,bhsv->bhtv", A, vc)
        G_last = G[:, :, -1:, :]
        S = jnp.exp(G_last[:, :, 0, :, None]) * S + jnp.einsum("bhsd,bhsv->bhdv", kc * jnp.exp(G_last - G), vc)
        return S, o

    S, o = lax.scan(step, s0.astype(jnp.float32), blocks)
    return from_blocks(o, T), S


def chunk_gated_delta(q, k, v, log_a, beta, s0):
    T = q.shape[1]
    n = -(-T // REC_BLOCK)
    dv = v.shape[-1]
    incl = jnp.tril(jnp.ones((REC_BLOCK, REC_BLOCK), dtype=bool))
    strict = jnp.tril(jnp.ones((REC_BLOCK, REC_BLOCK), dtype=bool), -1)
    eye = jnp.eye(REC_BLOCK, dtype=jnp.float32)
    blocks = tuple(to_blocks(a.astype(jnp.float32), n) for a in (q, k, v, log_a, beta))

    def step(S, blk):
        qc, kc, vc, gc, bc = blk
        G = jnp.cumsum(gc, axis=-1)
        rel = jnp.exp(jnp.where(incl, G[..., :, None] - G[..., None, :], -jnp.inf))
        M = jnp.where(strict, bc[..., :, None] * rel * jnp.einsum("bhtd,bhsd->bhts", kc, kc), 0.0)
        rhs = jnp.concatenate([bc[..., None] * vc, (bc * jnp.exp(G))[..., None] * kc], axis=-1)
        sol = lax.linalg.triangular_solve(eye + M, rhs, left_side=True, lower=True, unit_diagonal=True)
        u = sol[..., :dv] - jnp.einsum("bhtd,bhdv->bhtv", sol[..., dv:], S)
        qk = jnp.einsum("bhtd,bhsd->bhts", qc, kc) * rel
        o = jnp.einsum("bhtd,bhdv->bhtv", qc * jnp.exp(G)[..., None], S) + jnp.einsum("bhts,bhsv->bhtv", qk, u)
        S = jnp.exp(G[..., -1])[..., None, None] * S + jnp.einsum(
            "bhsd,bhsv->bhdv", kc * jnp.exp(G[..., -1:] - G)[..., None], u)
        return S, o

    S, o = lax.scan(step, s0.astype(jnp.float32), blocks)
    return from_blocks(o, T), S


def causal_conv(u, buf, w):
    T = u.shape[1]
    ext = jnp.concatenate([buf.astype(u.dtype), u], axis=1)
    y = ext[:, 0:T] * w[0]
    for j in range(1, CONV_W):
        y = y + ext[:, j:j + T] * w[j]
    return jax.nn.silu(y), ext[:, -(CONV_W - 1):]


def mixer(h, lb, s_hg, s_gdn, s_conv, w_in, hg_norm, conv_w, a_log, dt_bias, gdn_norm, w_pa, w_pb, w_out):
    B, T, _ = h.shape
    proj = h @ w_in
    hq, hf, hi, hog, gq, gk, gv, ga, gb, gz, gate_a, gate_b = split_cols(proj, IN_SIZES)
    heads = lambda a, d: a.reshape(B, T, -1, d)

    hf = hf.astype(jnp.float32)
    lb = lb.astype(jnp.float32)
    log_f = jnp.logaddexp(jnp.log(lb), jnp.log1p(-lb) + jax.nn.log_sigmoid(hf))
    k_hg = (1.0 - lb) * jax.nn.sigmoid(-hf)
    o_hg, s_hg_new = chunk_gla(heads(hq.astype(jnp.float32), HG_DK) * HG_DK ** -0.5, heads(k_hg, HG_DK),
                               heads(hi, HG_DV), heads(log_f, HG_DK), s_hg)
    o_hg = rmsnorm(o_hg, hg_norm) * jax.nn.silu(heads(hog, HG_DV).astype(jnp.float32))

    conv_out, s_conv_new = causal_conv(jnp.concatenate([gq, gk, gv], axis=-1), s_conv, conv_w)
    cq, ck, cv = split_cols(conv_out, (GDN_QK, GDN_QK, GDN_V))
    q = l2norm(heads(cq, GDN_DK)) * GDN_DK ** -0.5
    k = l2norm(heads(ck, GDN_DK))
    v = heads(cv, GDN_DV)
    log_a = -jnp.exp(a_log.astype(jnp.float32)) * jax.nn.softplus(ga.astype(jnp.float32) + dt_bias.astype(jnp.float32))
    beta = jax.nn.sigmoid(gb.astype(jnp.float32))
    o_gdn, s_gdn_new = chunk_gated_delta(q, k, v, log_a, beta, s_gdn)
    o_gdn = rmsnorm(o_gdn, gdn_norm) * jax.nn.silu(heads(gz, GDN_DV).astype(jnp.float32))

    y_a = o_hg.reshape(B, T, HG_V).astype(h.dtype) @ w_pa
    y_b = o_gdn.reshape(B, T, GDN_V).astype(h.dtype) @ w_pb
    y = jax.nn.sigmoid(gate_a) * y_a + jax.nn.sigmoid(gate_b) * y_b
    return y @ w_out, s_hg_new, s_gdn_new, s_conv_new


def swiglu(h, w_up, w_down):
    gate, up = jnp.split(h @ w_up, 2, axis=-1)
    return (jax.nn.silu(gate) * up) @ w_down


def trunk(x, c, s_hg, s_gdn, s_conv, lbs, w_ada, b_ada, norm_mix, w_in, hg_norm, conv_w, gdn_a_log,
          gdn_dt_bias, gdn_norm, w_proj_a, w_proj_b, w_out, norm_ffn, w_up, w_down, final_norm):
    new_hg, new_gdn, new_conv = [], [], []
    for l in range(DEPTH):
        mod = jax.nn.silu(c) @ w_ada[l] + b_ada[l]
        sh1, sc1, g1, sh2, sc2, g2 = [m[:, None, :] for m in jnp.split(mod, N_MOD, axis=-1)]
        h = rmsnorm(x, norm_mix[l]) * (1.0 + sc1) + sh1
        y, hg, gd, cv = mixer(h, lbs[l], s_hg[l], s_gdn[l], s_conv[l], w_in[l], hg_norm[l], conv_w[l],
                              gdn_a_log[l], gdn_dt_bias[l], gdn_norm[l], w_proj_a[l], w_proj_b[l], w_out[l])
        x = x + g1 * y
        h = rmsnorm(x, norm_ffn[l]) * (1.0 + sc2) + sh2
        x = x + g2 * swiglu(h, w_up[l], w_down[l])
        new_hg.append(hg)
        new_gdn.append(gd)
        new_conv.append(cv)
    return rmsnorm(x, final_norm), jnp.stack(new_hg), jnp.stack(new_gdn), jnp.stack(new_conv)


def setup_inputs(seed: int = 0) -> dict:
    key = jax.random.key(seed)
    ks = jax.random.split(key, 24)
    nrm = lambda k, shape, scale: jax.random.normal(k, shape, jnp.float32) * scale
    dt = jnp.exp(jax.random.uniform(ks[15], (DEPTH, GDN_HEADS), jnp.float32, math.log(1e-3), math.log(1e-1)))
    return {
        "x_prompt": nrm(ks[0], (BATCH, SEQ, D_MODEL), 1.0),
        "x_sample": nrm(ks[1], (DEC_BATCH, DEC_SEQ, D_MODEL), 1.0),
        "state_hgrn": nrm(ks[2], (DEPTH, DEC_BATCH, HG_HEADS, HG_DK, HG_DV), 0.5),
        "state_gdn": nrm(ks[3], (DEPTH, DEC_BATCH, GDN_HEADS, GDN_DK, GDN_DV), 0.1),
        "state_conv": nrm(ks[4], (DEPTH, DEC_BATCH, CONV_W - 1, CONV_CH), 1.0),
        "c_prompt": nrm(ks[5], (BATCH, D_MODEL), 1.0),
        "c_sample": nrm(ks[6], (DEC_BATCH, D_MODEL), 1.0),
        "w_ada": nrm(ks[7], (DEPTH, D_MODEL, N_MOD * D_MODEL), 0.5 * D_MODEL ** -0.5),
        "b_ada": nrm(ks[8], (DEPTH, N_MOD * D_MODEL), 0.02),
        "norm_mix": 1.0 + nrm(ks[9], (DEPTH, D_MODEL), 0.02),
        "w_in": nrm(ks[10], (DEPTH, D_MODEL, D_IN), D_MODEL ** -0.5),
        "hg_lb": nrm(ks[11], (DEPTH, HG_QK), 1.0),
        "hg_norm": 1.0 + nrm(ks[12], (DEPTH, HG_DV), 0.02),
        "conv_w": nrm(ks[13], (DEPTH, CONV_W, CONV_CH), CONV_W ** -0.5),
        "gdn_a_log": jnp.log(jax.random.uniform(ks[14], (DEPTH, GDN_HEADS), jnp.float32, 1.0, 16.0)),
        "gdn_dt_bias": dt + jnp.log(-jnp.expm1(-dt)),
        "gdn_norm": 1.0 + nrm(ks[16], (DEPTH, GDN_DV), 0.02),
        "w_proj_a": nrm(ks[17], (DEPTH, HG_V, D_MODEL), HG_V ** -0.5),
        "w_proj_b": nrm(ks[18], (DEPTH, GDN_V, D_MODEL), GDN_V ** -0.5),
        "w_out": nrm(ks[19], (DEPTH, D_MODEL, D_MODEL), D_MODEL ** -0.5),
        "norm_ffn": 1.0 + nrm(ks[20], (DEPTH, D_MODEL), 0.02),
        "w_up": nrm(ks[21], (DEPTH, D_MODEL, 2 * D_FF), D_MODEL ** -0.5),
        "w_down": nrm(ks[22], (DEPTH, D_FF, D_MODEL), D_FF ** -0.5),
        "final_norm": 1.0 + nrm(ks[23], (D_MODEL,), 0.02),
    }


def reference(x_prompt, x_sample, state_hgrn, state_gdn, state_conv, c_prompt, c_sample, w_ada, b_ada,
              norm_mix, w_in, hg_lb, hg_norm, conv_w, gdn_a_log, gdn_dt_bias, gdn_norm, w_proj_a, w_proj_b,
              w_out, norm_ffn, w_up, w_down, final_norm):
    lbs = jnp.cumsum(jax.nn.softmax(hg_lb.astype(jnp.float32), axis=0), axis=0)
    lbs = lbs - lbs[0:1]
    weights = (w_ada, b_ada, norm_mix, w_in, hg_norm, conv_w, gdn_a_log, gdn_dt_bias, gdn_norm,
               w_proj_a, w_proj_b, w_out, norm_ffn, w_up, w_down, final_norm)

    B = x_prompt.shape[0]
    zero_hg = jnp.zeros((DEPTH, B, HG_HEADS, HG_DK, HG_DV), jnp.float32)
    zero_gdn = jnp.zeros((DEPTH, B, GDN_HEADS, GDN_DK, GDN_DV), jnp.float32)
    zero_conv = jnp.zeros((DEPTH, B, CONV_W - 1, CONV_CH), x_prompt.dtype)
    y_prompt, hg_p, gdn_p, conv_p = trunk(x_prompt, c_prompt, zero_hg, zero_gdn, zero_conv, lbs, *weights)

    y_sample, hg_s, gdn_s, conv_s = trunk(x_sample, c_sample, state_hgrn, state_gdn, state_conv, lbs, *weights)

    return (y_prompt, y_sample, hg_p, gdn_p, conv_p, hg_s, gdn_s, conv_s)
```

```cpp
#include <hip/hip_runtime.h>
#include <hip/hip_cooperative_groups.h>
#include <cstdio>
namespace cg = cooperative_groups;

namespace pg8 {
#define PG8_LAS __attribute__((address_space(3)))
typedef unsigned short bf16_t;
typedef short bf16x8 __attribute__((ext_vector_type(8)));
typedef float f32x4 __attribute__((ext_vector_type(4)));
typedef unsigned u32x4 __attribute__((ext_vector_type(4)));
constexpr int BM = 256, BK = 64, HALF = 128, HTB = HALF * BK * 2  , STAGE_BYTES = 8 * HTB, NXCD = 8, WGM = 8;

__host__ __device__ __forceinline__ int lds_byte(int r, int c) { const int st = (r >> 4) * 2 + (c >> 5), rr = r & 15, cc = c & 31, ob = rr * 64 + cc * 2; return st * 1024 + (ob ^ (((ob >> 9) & 1) << 5)); }
__host__ __device__ __forceinline__ void stage_rc(int b, int& R, int& C) { const int st = b / 1024, sb = b % 1024, swz = sb ^ (((sb >> 9) & 1) << 5); R = (st >> 1) * 16 + swz / 64; C = (st & 1) * 32 + (swz % 64) / 2; }
__host__ __device__ __forceinline__ int perm32(int rho) { const int n = rho >> 4, i = rho & 15; return 8 * (i >> 2) + 4 * n + (i & 3); }

struct Unit { int pm, pn, ko; };
struct Gemm { const bf16_t* A; const bf16_t* Bt; int M, N, K, ld; };

struct StaticOrder {
    int nM, nN, nwg, G, c;
    __host__ __device__ void init(int M, int N, int G_, int c_) { nM = M / BM; nN = N / BM; nwg = nM * nN; G = G_; c = c_; }
    __host__ __device__ bool next(int i, Unit& u) const {
        const long L = (long)i * G + c; if (L >= nwg) return false;
        int wgid = (int)L; { const int q = nwg / NXCD, r = nwg % NXCD, xcd = wgid % NXCD, off = wgid / NXCD; wgid = (xcd < r ? xcd * (q + 1) : r * (q + 1) + (xcd - r) * q) + off; }
        const int nig = WGM * nN, gid = wgid / nig, fm = gid * WGM, gsz = (nM - fm) < WGM ? (nM - fm) : WGM;
        u.pm = fm + ((wgid % nig) % gsz); u.pn = (wgid % nig) / gsz; u.ko = 0; return true;
    }
    __device__ __forceinline__ void a_ready(const Unit&) const {}
    __device__ __forceinline__ void done(const Unit&) const {}
};
__device__ __forceinline__ unsigned cvt_pk_bf16(float lo, float hi) { unsigned r; asm volatile("v_cvt_pk_bf16_f32 %0, %1, %2" : "=v"(r) : "v"(lo), "v"(hi)); return r; }
template <class Epi, class Sched>
__device__ __forceinline__ void gemm_phase(PG8_LAS unsigned char* lds, const Gemm g, const Sched& S, const Epi& E) {
    const int tid = threadIdx.x, wid = __builtin_amdgcn_readfirstlane(tid >> 6), lane = tid & 63, wr = wid >> 2, wc = wid & 3, fr = lane & 15, fq = lane >> 4;
    const int K = g.ld, nt = g.K / BK;
    unsigned voffA[2], voffB[2];
#pragma unroll
    for (int i = 0; i < 2; ++i) { int R, C; stage_rc(tid * 16 + i * 8192, R, C); const int Rb = Epi::PERM ? ((R & ~31) + perm32(R & 31)) : R;
        voffA[i] = (unsigned)(R * K + C) * 2u; voffB[i] = (unsigned)(Rb * K + C) * 2u; }
    const size_t kstep = (size_t)(BK * 2);
    const size_t hstep = (size_t)HALF * K * 2;
    const size_t tstep = 2 * hstep;
    const unsigned ldsw = (unsigned)wid * 1024u;
    const int aoff = lds_byte(wr * 64 + fr, fq * 8), boff = lds_byte(wc * 32 + fr, fq * 8);
#define PG8_SA(b, h) (((b) * 2 + (h)) * HTB)
#define PG8_SB(b, h) ((4 + (b) * 2 + (h)) * HTB)
#define PG8_STAGE(bufoff, gbase, voff) do { _Pragma("unroll") for (int _i = 0; _i < 2; ++_i) \
        __builtin_amdgcn_global_load_lds((const unsigned*)((const char*)(gbase) + (voff)[_i]), (PG8_LAS unsigned*)(lds + (bufoff) + ldsw + _i * 8192), 16, 0, 0); } while (0)
#define PG8_LDA(dst, b, h) do { _Pragma("unroll") for (int m = 0; m < 4; ++m) _Pragma("unroll") for (int k = 0; k < 2; ++k) dst[m][k] = *(const PG8_LAS bf16x8*)(lds + PG8_SA(b, h) + aoff + m * 2048 + k * 1024); } while (0)
#define PG8_LDB(dst, b, h) do { _Pragma("unroll") for (int n = 0; n < 2; ++n) _Pragma("unroll") for (int k = 0; k < 2; ++k) dst[n][k] = *(const PG8_LAS bf16x8*)(lds + PG8_SB(b, h) + boff + n * 2048 + k * 1024); } while (0)
#define PG8_MMA(ai, bj, At, Bt) do { __builtin_amdgcn_s_setprio(1); _Pragma("unroll") for (int m = 0; m < 4; ++m) _Pragma("unroll") for (int n = 0; n < 2; ++n) _Pragma("unroll") for (int k = 0; k < 2; ++k) \
        acc[ai][bj][m][n] = __builtin_amdgcn_mfma_f32_16x16x32_bf16(Bt[n][k], At[m][k], acc[ai][bj][m][n], 0, 0, 0); __builtin_amdgcn_s_setprio(0); } while (0)
#define PG8_WAIT_V(n) asm volatile("s_waitcnt vmcnt(" #n ")" ::: "memory")
#define PG8_WAIT_L(n) asm volatile("s_waitcnt lgkmcnt(" #n ")" ::: "memory")
#define PG8_BAR __builtin_amdgcn_s_barrier()
#define PG8_SCHED __builtin_amdgcn_sched_barrier(0)
    Unit cur, nxt; int ui = 0;
    if (!S.next(0, cur)) return;
    f32x4 acc[2][2][4][2];
#pragma unroll
    for (int a = 0; a < 2; ++a)
#pragma unroll
        for (int b = 0; b < 2; ++b)
#pragma unroll
            for (int m = 0; m < 4; ++m)
#pragma unroll
                for (int n = 0; n < 2; ++n) acc[a][b][m][n] = (f32x4){0.f, 0.f, 0.f, 0.f};
    bf16x8 At[4][2], B0[2][2], B1[2][2];
    const char* cA = (const char*)g.A + (size_t)cur.pm * tstep + (size_t)cur.ko * 2; const char* cB = (const char*)g.Bt + (size_t)cur.pn * tstep + (size_t)cur.ko * 2;
    S.a_ready(cur);
    PG8_STAGE(PG8_SB(0, 0), cB, voffB); PG8_STAGE(PG8_SA(0, 0), cA, voffA); PG8_STAGE(PG8_SB(0, 1), cB + hstep, voffB); PG8_STAGE(PG8_SA(0, 1), cA + hstep, voffA);
    if (wr == 1) PG8_BAR;
    PG8_WAIT_V(4); PG8_BAR;
    PG8_STAGE(PG8_SB(1, 0), cB + kstep, voffB); PG8_STAGE(PG8_SA(1, 0), cA + kstep, voffA); PG8_STAGE(PG8_SB(1, 1), cB + hstep + kstep, voffB);
    PG8_WAIT_V(6); PG8_BAR;
    for (;;) {
        const bool has_next = S.next(ui + 1, nxt);
        const char* nA = has_next ? (const char*)g.A + (size_t)nxt.pm * tstep + (size_t)nxt.ko * 2 : cA; const char* nB = has_next ? (const char*)g.Bt + (size_t)nxt.pn * tstep + (size_t)nxt.ko * 2 : cB;
        for (int t = 0; t < nt; t += 2) {
            const bool last = (t == nt - 2);
            const char* a1 = cA + (size_t)(t + 1) * kstep;
            const char* a2 = last ? nA : cA + (size_t)(t + 2) * kstep; const char* b2 = last ? nB : cB + (size_t)(t + 2) * kstep;
            const char* a3 = a2 + kstep; const char* b3 = b2 + kstep;
            if (last && has_next) S.a_ready(nxt);
            PG8_LDB(B0, 0, 0); PG8_SCHED; PG8_LDA(At, 0, 0); PG8_STAGE(PG8_SA(1, 1), a1 + hstep, voffA);
            PG8_WAIT_L(8); PG8_BAR; PG8_WAIT_L(0); PG8_MMA(0, 0, At, B0); PG8_BAR; PG8_SCHED;
            PG8_LDB(B1, 0, 1); PG8_STAGE(PG8_SB(0, 0), b2, voffB);
            PG8_BAR; PG8_WAIT_L(0); PG8_MMA(0, 1, At, B1); PG8_BAR;
            PG8_LDA(At, 0, 1); PG8_STAGE(PG8_SA(0, 0), a2, voffA);
            PG8_BAR; PG8_WAIT_L(0); PG8_MMA(1, 0, At, B0); PG8_BAR; PG8_SCHED;
            PG8_STAGE(PG8_SB(0, 1), b2 + hstep, voffB);
            PG8_WAIT_V(6); PG8_BAR; PG8_MMA(1, 1, At, B1); PG8_BAR;
            PG8_LDB(B0, 1, 0); PG8_SCHED; PG8_LDA(At, 1, 0); PG8_STAGE(PG8_SA(0, 1), a2 + hstep, voffA);
            PG8_WAIT_L(8); PG8_BAR; PG8_WAIT_L(0); PG8_MMA(0, 0, At, B0); PG8_BAR; PG8_SCHED;
            PG8_LDB(B1, 1, 1); PG8_STAGE(PG8_SB(1, 0), b3, voffB);
            PG8_BAR; PG8_WAIT_L(0); PG8_MMA(0, 1, At, B1); PG8_BAR;
            PG8_LDA(At, 1, 1); PG8_STAGE(PG8_SA(1, 0), a3, voffA);
            PG8_BAR; PG8_WAIT_L(0); PG8_MMA(1, 0, At, B0); PG8_BAR; PG8_SCHED;
            PG8_STAGE(PG8_SB(1, 1), b3 + hstep, voffB);
            PG8_WAIT_V(6); PG8_BAR; PG8_MMA(1, 1, At, B1); PG8_BAR;
        }
        if constexpr (!Epi::AFTER_DRAIN) { E(acc, cur, wr, wc, fr, fq); S.done(cur); }
        if (!has_next) break;
#pragma unroll
        for (int a = 0; a < 2; ++a)
#pragma unroll
            for (int b = 0; b < 2; ++b)
#pragma unroll
                for (int m = 0; m < 4; ++m)
#pragma unroll
                    for (int n = 0; n < 2; ++n) acc[a][b][m][n] = (f32x4){0.f, 0.f, 0.f, 0.f};
        cur = nxt; cA = nA; cB = nB; ++ui;
    }
    PG8_WAIT_V(0);
    if (wr == 0) PG8_BAR;
    PG8_BAR;
    if constexpr (Epi::AFTER_DRAIN) { E.fused(acc, cur, wr, wc, fr, fq, lds, wid, lane); S.done(cur); }
#undef PG8_SA
#undef PG8_SB
#undef PG8_STAGE
#undef PG8_LDA
#undef PG8_LDB
#undef PG8_MMA
#undef PG8_WAIT_V
#undef PG8_WAIT_L
#undef PG8_BAR
#undef PG8_SCHED
}
}

using pg8::bf16_t; using pg8::bf16x8; using pg8::f32x4; using pg8::u32x4; using pg8::Unit;
#define LAS __attribute__((address_space(3)))

constexpr int NPROW = 32768, MROWS = 33792;
constexpr size_t SEGSZ = (size_t)MROWS * 512;
constexpr size_t WT_IN = 0, WT_PA = WT_IN + (size_t)6144 * 1024, WT_PB = WT_PA + (size_t)1024 * 512, WT_OUT = WT_PB + (size_t)1024 * 512,
                 WT_UP = WT_OUT + (size_t)1024 * 1024, WT_DOWN = WT_UP + (size_t)5632 * 1024, WT_LAYER = WT_DOWN + (size_t)1024 * 2816;
constexpr size_t WS_WT = 0;
constexpr size_t WS_SEG = WS_WT + 2 * WT_LAYER * 2;
constexpr size_t WS_H = WS_SEG + 8 * SEGSZ * 2;
constexpr size_t WS_MOD = WS_H + (size_t)MROWS * 1024 * 2;
constexpr size_t WS_GAB = WS_MOD + (size_t)2 * 48 * 6144 * 4;
constexpr size_t WS_LB = WS_GAB + (size_t)MROWS * 8 * 4;
constexpr size_t WS_E0 = WS_LB + 1024 * 4;
constexpr size_t WS_DG = WS_E0 + 3 * SEGSZ * 2;
constexpr size_t WS_AL = WS_DG + (size_t)4224 * 128 * 4;
constexpr size_t WS_BAR = WS_AL + 4224 * 4 + 128;
constexpr size_t WS_HALO = WS_BAR + 16384;
constexpr size_t WS_END = WS_HALO + (size_t)1056 * 3 * 1536 * 2;
constexpr size_t O_HGP = 34603008, O_GDP = O_HGP + 2097152, O_CVP = O_GDP + 2097152, O_HGS = O_CVP + 147456, O_GDS = O_HGS + 4194304, O_CVS = O_GDS + 4194304;

struct Params { const float* in[24]; float* out; unsigned char* ws; int ph0, ph1; };

__device__ __forceinline__ void unpack8(const u32x4 w, float* f) {
    f[0] = __uint_as_float(w.x << 16); f[1] = __uint_as_float(w.x & 0xffff0000u); f[2] = __uint_as_float(w.y << 16); f[3] = __uint_as_float(w.y & 0xffff0000u);
    f[4] = __uint_as_float(w.z << 16); f[5] = __uint_as_float(w.z & 0xffff0000u); f[6] = __uint_as_float(w.w << 16); f[7] = __uint_as_float(w.w & 0xffff0000u);
}
__device__ __forceinline__ u32x4 pack8(const float* f) {
    u32x4 w; w.x = pg8::cvt_pk_bf16(f[0], f[1]); w.y = pg8::cvt_pk_bf16(f[2], f[3]); w.z = pg8::cvt_pk_bf16(f[4], f[5]); w.w = pg8::cvt_pk_bf16(f[6], f[7]); return w;
}
__device__ __forceinline__ float sigm(float x) { return __builtin_amdgcn_rcpf(1.0f + __expf(-x)); }
__device__ __forceinline__ float silu_(float x) { return x * __builtin_amdgcn_rcpf(1.0f + __expf(-x)); }
__device__ __forceinline__ float silu_fast(float x) { return x * __builtin_amdgcn_rcpf(1.0f + __expf(-x)); }
__device__ __forceinline__ int seq_of(int r) { return r < NPROW ? (r >> 11) : 16 + ((r - NPROW) >> 5); }

template <int MODE> struct EpiB {
    static constexpr bool PERM = true, AFTER_DRAIN = false;
    bf16_t* O; int ldc; int split_cols; size_t split_stride; const bf16_t* G; bf16_t* HALO;
    __device__ __forceinline__ void operator()(const f32x4 (&acc)[2][2][4][2], const Unit& u, int wr, int wc, int fr, int fq) const {
        asm volatile("" : "+v"(fr), "+v"(fq));
        const int row0 = u.pm * 256 + wr * 64 + fr; int colt = u.pn * 256; bf16_t* base = O;
        if (split_cols) { const int t = colt / split_cols; base += (size_t)t * split_stride; colt -= t * split_cols; }
        const int col0 = colt + wc * 32 + 8 * fq, gcol0 = u.pn * 256 + wc * 32 + 8 * fq;
#pragma unroll
        for (int aim = 0; aim < 4; ++aim) {
            const int ai = aim >> 1;
            u32x4 gq[4][2], oq[4][2];
            if (MODE == 2 || MODE == 3) {
#pragma unroll
                for (int mm = 0; mm < 2; ++mm)
#pragma unroll
                    for (int bj = 0; bj < 2; ++bj) {
                        const int m = (aim & 1) * 2 + mm, r = row0 + ai * 128 + m * 16;
                        gq[m][bj] = *(const u32x4*)(G + (size_t)r * 1024 + gcol0 + bj * 128);
                        if (MODE == 3) oq[m][bj] = *(const u32x4*)(base + (size_t)r * ldc + col0 + bj * 128);
                    }
            }
#pragma unroll
            for (int m = (aim & 1) * 2; m < (aim & 1) * 2 + 2; ++m) {
                const int r = row0 + ai * 128 + m * 16;
                bf16_t* rowp = base + (size_t)r * ldc + col0;
#pragma unroll
                for (int bj = 0; bj < 2; ++bj) {
                    float v[8];
#pragma unroll
                    for (int j = 0; j < 4; ++j) { v[j] = acc[ai][bj][m][0][j]; v[4 + j] = acc[ai][bj][m][1][j]; }
                    if (MODE == 1) {
#pragma unroll
                        for (int j = 0; j < 8; ++j) v[j] = sigm(v[j]);
                        asm volatile("s_nop 1" : "+v"(v[0]), "+v"(v[1]), "+v"(v[2]), "+v"(v[3]), "+v"(v[4]), "+v"(v[5]), "+v"(v[6]), "+v"(v[7]));
                    }
                    if (MODE == 2 || MODE == 3) {
                        float g[8]; unpack8(gq[m][bj], g);
#pragma unroll
                        for (int j = 0; j < 8; ++j) v[j] *= g[j];
                    }
                    if (MODE == 3) {
                        float o[8]; unpack8(oq[m][bj], o);
#pragma unroll
                        for (int j = 0; j < 8; ++j) v[j] += o[j];
                    }
                    const u32x4 pk = pack8(v);
                    *(u32x4*)(rowp + bj * 128) = pk;
                    if (MODE == 4) {
                        const int sg = (u.pn * 256) / 512;
                        if (sg >= 4 && sg <= 6 && (m & 1) && fr >= 13)
                            *(u32x4*)(HALO + ((size_t)(r >> 5) * 3 + ((r & 31) - 29)) * 1536 + (sg - 4) * 512 + col0 + bj * 128) = pk;
                    }
                }
            }
        }
    }
};
struct EpiUp {
    static constexpr bool PERM = true, AFTER_DRAIN = false;
    bf16_t* O;
    __device__ __forceinline__ void operator()(const f32x4 (&acc)[2][2][4][2], const Unit& u, int wr, int wc, int fr, int fq) const {
        asm volatile("" : "+v"(fr), "+v"(fq));
        const int row0 = u.pm * 256 + wr * 64 + fr, col0 = u.pn * 128 + wc * 32 + 8 * fq;
#pragma unroll
        for (int ai = 0; ai < 2; ++ai)
#pragma unroll
            for (int m = 0; m < 4; ++m) {
                const int r = row0 + ai * 128 + m * 16;
                float v[8];
#pragma unroll
                for (int j = 0; j < 4; ++j) { v[j] = silu_fast(acc[ai][0][m][0][j]) * acc[ai][1][m][0][j]; v[4 + j] = silu_fast(acc[ai][0][m][1][j]) * acc[ai][1][m][1][j]; }
                *(u32x4*)(O + (size_t)r * 2816 + col0) = pack8(v);
            }
    }
};
struct EpiRes {
    static constexpr bool PERM = false, AFTER_DRAIN = false;
    const float* xp; const float* xs; float* X; const float* modg;
    __device__ __forceinline__ void operator()(const f32x4 (&acc)[2][2][4][2], const Unit& u, int wr, int wc, int fr, int fq) const {
        asm volatile("" : "+v"(fr), "+v"(fq));
        const int row0 = u.pm * 256 + wr * 64 + fr, col0 = u.pn * 256 + wc * 32 + 4 * fq;
#pragma unroll
        for (int ai = 0; ai < 2; ++ai)
#pragma unroll
            for (int m = 0; m < 4; ++m) {
                const int r = row0 + ai * 128 + m * 16;
                const float* gp = modg + (size_t)seq_of(r) * 6144 + col0;
                const float* xr = (r < NPROW ? xp + (size_t)r * 1024 : xs + (size_t)(r - NPROW) * 1024) + col0;
                float* xo = X + (size_t)r * 1024 + col0;
#pragma unroll
                for (int bj = 0; bj < 2; ++bj)
#pragma unroll
                    for (int n = 0; n < 2; ++n) {
                        const int c = bj * 128 + n * 16;
                        const f32x4 g4 = *(const f32x4*)(gp + c), x4 = *(const f32x4*)(xr + c);
                        *(f32x4*)(xo + c) = x4 + g4 * acc[ai][bj][m][n];
                    }
            }
    }
};

struct SliceOrder {
    int pm0, nN, nks, Ks, n, G, c;
    __device__ __forceinline__ bool next(int i, Unit& u) const {
        const int L = i * G + c; if (L >= n) return false;
        const int tile = L / nks, ks = L - tile * nks;
        u.pm = pm0 + tile / nN; u.pn = tile % nN; u.ko = ks * Ks; return true;
    }
    __device__ __forceinline__ void a_ready(const Unit&) const {}
    __device__ __forceinline__ void done(const Unit&) const {}
};
struct EpiRes2 {
    static constexpr bool PERM = false, AFTER_DRAIN = false, PAIR = false;
    const float* xs; float* X; float* T; const float* modg;
    __device__ __forceinline__ void operator()(const f32x4 (&acc)[2][2][4][2], const Unit& u, int wr, int wc, int fr, int fq) const {
        asm volatile("" : "+v"(fr), "+v"(fq));
        const int row0 = u.pm * 256 + wr * 64 + fr, col0 = u.pn * 256 + wc * 32 + 4 * fq;
        const bool first = (u.ko == 0);
#pragma unroll
        for (int aim = 0; aim < 4; ++aim) {
            const int ai = aim >> 1, m0 = (aim & 1) * 2;
            f32x4 g4[2][2], x4[2][2][2];
            {
                const float* gp = modg + (size_t)seq_of(row0 + ai * 128 + m0 * 16) * 6144 + col0;
#pragma unroll
                for (int bj = 0; bj < 2; ++bj)
#pragma unroll
                    for (int n = 0; n < 2; ++n) g4[bj][n] = *(const f32x4*)(gp + bj * 128 + n * 16);
            }
            if (first) {
#pragma unroll
                for (int mm = 0; mm < 2; ++mm) {
                    const float* xr = xs + (size_t)(row0 + ai * 128 + (m0 + mm) * 16 - NPROW) * 1024 + col0;
#pragma unroll
                    for (int bj = 0; bj < 2; ++bj)
#pragma unroll
                        for (int n = 0; n < 2; ++n) x4[mm][bj][n] = *(const f32x4*)(xr + bj * 128 + n * 16);
                }
            }
#pragma unroll
            for (int mm = 0; mm < 2; ++mm) {
                const int r = row0 + ai * 128 + (m0 + mm) * 16;
                float* xo = X + (size_t)r * 1024 + col0; float* to = T + (size_t)(r - NPROW) * 1024 + col0;
#pragma unroll
                for (int bj = 0; bj < 2; ++bj)
#pragma unroll
                    for (int n = 0; n < 2; ++n) {
                        const int c = bj * 128 + n * 16;
                        if (first) *(f32x4*)(xo + c) = x4[mm][bj][n] + g4[bj][n] * acc[ai][bj][m0 + mm][n];
                        else *(f32x4*)(to + c) = g4[bj][n] * acc[ai][bj][m0 + mm][n];
                    }
            }
        }
    }
};

struct EpiResU {
    static constexpr bool PERM = false, AFTER_DRAIN = false;
    const float* xin; float* X; const float* modg;
    __device__ __forceinline__ void operator()(const f32x4 (&acc)[2][2][4][2], const Unit& u, int wr, int wc, int fr, int fq) const {
        asm volatile("" : "+v"(fr), "+v"(fq));
        const int row0 = u.pm * 256 + wr * 64 + fr, col0 = u.pn * 256 + wc * 32 + 4 * fq;
        const float* gp = modg + (size_t)((u.pm * 256) >> 11) * 6144 + col0;
        f32x4 g4[2][2];
#pragma unroll
        for (int bj = 0; bj < 2; ++bj)
#pragma unroll
            for (int n = 0; n < 2; ++n) g4[bj][n] = *(const f32x4*)(gp + bj * 128 + n * 16);
#pragma unroll
        for (int aim = 0; aim < 4; ++aim) {
            const int ai = aim >> 1, m0 = (aim & 1) * 2;
            f32x4 x[2][2][2];
#pragma unroll
            for (int mm = 0; mm < 2; ++mm) {
                const float* xr = xin + (size_t)(row0 + ai * 128 + (m0 + mm) * 16) * 1024 + col0;
#pragma unroll
                for (int bj = 0; bj < 2; ++bj)
#pragma unroll
                    for (int n = 0; n < 2; ++n) x[mm][bj][n] = *(const f32x4*)(xr + bj * 128 + n * 16);
            }
#pragma unroll
            for (int mm = 0; mm < 2; ++mm) {
                float* xo = X + (size_t)(row0 + ai * 128 + (m0 + mm) * 16) * 1024 + col0;
#pragma unroll
                for (int bj = 0; bj < 2; ++bj)
#pragma unroll
                    for (int n = 0; n < 2; ++n) *(f32x4*)(xo + bj * 128 + n * 16) = x[mm][bj][n] + g4[bj][n] * acc[ai][bj][m0 + mm][n];
            }
        }
    }
};

struct WTile { const float* src; bf16_t* dst; int ld, K, k0, n0, col0; };
__device__ __forceinline__ WTile wtile_of(const Params& p, int t) {
    WTile w; const int l = t / 4160; int r = t % 4160; int ntn, mp = 0;
    bf16_t* dst = (bf16_t*)(p.ws + WS_WT) + (size_t)l * WT_LAYER;
    if (r < 1536) { w.src = p.in[10] + (size_t)l * 1024 * 6152; w.ld = 6152; w.K = 1024; ntn = 96; dst += WT_IN; mp = 1; }
    else if (r < 1664) { r -= 1536; w.src = p.in[17] + (size_t)l * 512 * 1024; w.ld = 1024; w.K = 512; ntn = 16; dst += WT_PA; }
    else if (r < 1792) { r -= 1664; w.src = p.in[18] + (size_t)l * 512 * 1024; w.ld = 1024; w.K = 512; ntn = 16; dst += WT_PB; }
    else if (r < 2048) { r -= 1792; w.src = p.in[19] + (size_t)l * 1024 * 1024; w.ld = 1024; w.K = 1024; ntn = 16; dst += WT_OUT; }
    else if (r < 3456) { r -= 2048; w.src = p.in[21] + (size_t)l * 1024 * 5632; w.ld = 5632; w.K = 1024; ntn = 88; dst += WT_UP; mp = 2; }
    else { r -= 3456; w.src = p.in[22] + (size_t)l * 2816 * 1024; w.ld = 1024; w.K = 2816; ntn = 16; dst += WT_DOWN; }
    w.dst = dst; w.k0 = (r / ntn) * 64; w.n0 = (r % ntn) * 64; w.col0 = w.n0;
    if (mp == 1) w.col0 = w.n0 < 3584 ? w.n0 : w.n0 + 8;
    if (mp == 2) { const int tt = w.n0 >> 8, i = w.n0 & 255; w.col0 = i < 128 ? 128 * tt + i : 2816 + 128 * tt + (i - 128); }
    return w;
}
__device__ __forceinline__ void convert_tiles(const Params& p, float* L, int t_lo, int t_hi, int rank, int nranks) {
    const int tid = threadIdx.x;
    f32x4 nv[2]; int t = t_lo + rank;
    const int r0 = tid >> 4, c4 = tid & 15;
    if (t < t_hi) { const WTile w = wtile_of(p, t); nv[0] = *(const f32x4*)(w.src + (size_t)(w.k0 + r0) * w.ld + w.col0 + c4 * 4); nv[1] = *(const f32x4*)(w.src + (size_t)(w.k0 + r0 + 32) * w.ld + w.col0 + c4 * 4); }
    while (t < t_hi) {
        const WTile w = wtile_of(p, t);
        const f32x4 v0 = nv[0], v1 = nv[1];
        const int tn = t + nranks;
        if (tn < t_hi) { const WTile wn = wtile_of(p, tn); nv[0] = *(const f32x4*)(wn.src + (size_t)(wn.k0 + r0) * wn.ld + wn.col0 + c4 * 4); nv[1] = *(const f32x4*)(wn.src + (size_t)(wn.k0 + r0 + 32) * wn.ld + wn.col0 + c4 * 4); }
        { float* tt = L + r0 * 65 + c4 * 4; tt[0] = v0[0]; tt[1] = v0[1]; tt[2] = v0[2]; tt[3] = v0[3]; tt += 32 * 65; tt[0] = v1[0]; tt[1] = v1[1]; tt[2] = v1[2]; tt[3] = v1[3]; }
        __syncthreads();
        {
            const int n = tid >> 3, k8 = tid & 7; float f[8];
#pragma unroll
            for (int e = 0; e < 8; ++e) f[e] = L[(k8 * 8 + e) * 65 + n];
            *(u32x4*)(w.dst + (size_t)(w.n0 + n) * w.K + w.k0 + k8 * 8) = pack8(f);
        }
        __syncthreads();
        t = tn;
    }
}

__device__ __forceinline__ void phase_prologue(const Params& p, float* L) {
    const int tid = threadIdx.x, wave = tid >> 6, lane = tid & 63;
    float* MOD = (float*)(p.ws + WS_MOD);
    if (blockIdx.x == 0) {
        float* LB = (float*)(p.ws + WS_LB);
        const float a = p.in[11][tid], b = p.in[11][512 + tid], m = fmaxf(a, b), ea = __expf(a - m), eb = __expf(b - m);
        LB[tid] = 0.0f; LB[512 + tid] = eb / (ea + eb);
    }
    for (int u = blockIdx.x; u < 192; u += gridDim.x) {
        const int l = u / 96, col = (u % 96) * 64 + lane;
        bf16_t* sC = (bf16_t*)L;
        __syncthreads();
        for (int i = tid; i < 48 * 512; i += 512) {
            const int row = i >> 9, k2 = (i & 511) * 2;
            const float* cp = row < 16 ? p.in[5] + row * 1024 + k2 : p.in[6] + (row - 16) * 1024 + k2;
            ((unsigned*)sC)[i] = pg8::cvt_pk_bf16(silu_(cp[0]), silu_(cp[1]));
        }
        __syncthreads();
        float acc[48];
#pragma unroll
        for (int j = 0; j < 48; ++j) acc[j] = 0.f;
        const float* wp = p.in[7] + ((size_t)l * 1024 + wave * 128) * 6144 + col;
        float wn[8];
#pragma unroll
        for (int e = 0; e < 8; ++e) wn[e] = wp[(size_t)e * 6144];
#pragma unroll 1
        for (int k = 0; k < 128; k += 8) {
            float w[8];
#pragma unroll
            for (int e = 0; e < 8; ++e) w[e] = wn[e];
            if (k + 8 < 128) {
#pragma unroll
                for (int e = 0; e < 8; ++e) wn[e] = wp[(size_t)(k + 8 + e) * 6144];
            }
#pragma unroll
            for (int j = 0; j < 48; ++j) {
                float c8[8]; unpack8(*(const u32x4*)(sC + j * 1024 + wave * 128 + k), c8);
#pragma unroll
                for (int e = 0; e < 8; ++e) acc[j] = fmaf(c8[e], w[e], acc[j]);
            }
        }
        __syncthreads();
#pragma unroll
        for (int j = 0; j < 48; ++j) L[(wave * 48 + j) * 64 + lane] = acc[j];
        __syncthreads();
        for (int i = tid; i < 48 * 64; i += 512) {
            float a = 0.f;
#pragma unroll
            for (int w8 = 0; w8 < 8; ++w8) a += L[w8 * 3072 + i];
            const int row = i >> 6, cc = (u % 96) * 64 + (i & 63);
            MOD[((size_t)l * 48 + row) * 6144 + cc] = a + p.in[8][l * 6144 + cc];
        }
    }
    __syncthreads();
    if (gridDim.x == 256) { if (blockIdx.x >= 192) convert_tiles(p, L, 0, 1536, (int)blockIdx.x - 192, 64); }
    else convert_tiles(p, L, 0, 8320, (int)blockIdx.x, (int)gridDim.x);
}

template <int MODE, int NR> __device__ __forceinline__ void norm_task(const Params& p, int l, const float* L, int row0, const f32x4 (&nw4)[4], int lane) {
    float* X = p.out; bf16_t* H = (bf16_t*)(p.ws + WS_H);
    const float* MOD = (const float*)(p.ws + WS_MOD) + (size_t)l * 48 * 6144;
    float* GAB = (float*)(p.ws + WS_GAB);
    const float* xr = (MODE == 0 && l == 0) ? (row0 < NPROW ? p.in[0] + (size_t)row0 * 1024 : p.in[1] + (size_t)(row0 - NPROW) * 1024) : X + (size_t)row0 * 1024;
    f32x4 v[NR][4];
#pragma unroll
    for (int rr = 0; rr < NR; ++rr)
#pragma unroll
        for (int i = 0; i < 4; ++i) v[rr][i] = *(const f32x4*)(xr + rr * 1024 + i * 256 + lane * 4);
    if (row0 >= NPROW && !(MODE == 0 && l == 0)) {
        const float* T = (const float*)(p.ws + WS_E0) + (MODE == 1 ? (size_t)1024 * 1024 : 0) + (size_t)(row0 - NPROW) * 1024;
#pragma unroll
        for (int rr = 0; rr < NR; ++rr)
#pragma unroll
            for (int i = 0; i < 4; ++i) {
                v[rr][i] += *(const f32x4*)(T + rr * 1024 + i * 256 + lane * 4);
                if (MODE != 2) *(f32x4*)(X + (size_t)(row0 + rr) * 1024 + i * 256 + lane * 4) = v[rr][i];
            }
    }
    f32x4 s4[4], b4[4];
    if (MODE != 2) {
        const float* sh = MOD + (size_t)seq_of(row0) * 6144 + (MODE == 0 ? 0 : 3072); const float* sc = sh + 1024;
#pragma unroll
        for (int i = 0; i < 4; ++i) { s4[i] = *(const f32x4*)(sc + i * 256 + lane * 4) + 1.0f; b4[i] = *(const f32x4*)(sh + i * 256 + lane * 4); }
    }
#pragma unroll
    for (int rr = 0; rr < NR; ++rr) {
        float ss = 0.f;
#pragma unroll
        for (int i = 0; i < 4; ++i) ss += v[rr][i][0] * v[rr][i][0] + v[rr][i][1] * v[rr][i][1] + v[rr][i][2] * v[rr][i][2] + v[rr][i][3] * v[rr][i][3];
#pragma unroll
        for (int o = 32; o >= 1; o >>= 1) ss += __shfl_xor(ss, o);
        const float rstd = rsqrtf(ss * (1.0f / 1024.0f) + 1e-6f);
        const int row = row0 + rr;
        if (MODE == 2) {
#pragma unroll
            for (int i = 0; i < 4; ++i) *(f32x4*)(X + (size_t)row * 1024 + i * 256 + lane * 4) = v[rr][i] * rstd * nw4[i];
        } else {
#pragma unroll
            for (int i = 0; i < 4; ++i) {
                v[rr][i] = (v[rr][i] * rstd * nw4[i]) * s4[i] + b4[i];
                typedef unsigned u32x2_ __attribute__((ext_vector_type(2)));
                u32x2_ w; w.x = pg8::cvt_pk_bf16(v[rr][i][0], v[rr][i][1]); w.y = pg8::cvt_pk_bf16(v[rr][i][2], v[rr][i][3]);
                *(u32x2_*)(H + (size_t)row * 1024 + i * 256 + lane * 4) = w;
            }
        }
    }
    if (MODE == 0) {
        float d[NR][8];
#pragma unroll
        for (int j = 0; j < 8; ++j) {
            f32x4 w4[4];
#pragma unroll
            for (int i = 0; i < 4; ++i) w4[i] = *(const f32x4*)(L + j * 1024 + i * 256 + lane * 4);
#pragma unroll
            for (int rr = 0; rr < NR; ++rr) {
                float a = 0.f;
#pragma unroll
                for (int i = 0; i < 4; ++i) a += v[rr][i][0] * w4[i][0] + v[rr][i][1] * w4[i][1] + v[rr][i][2] * w4[i][2] + v[rr][i][3] * w4[i][3];
#pragma unroll
                for (int o = 32; o >= 1; o >>= 1) a += __shfl_xor(a, o);
                d[rr][j] = a;
            }
        }
        if (lane < NR) {
            float dd[8];
#pragma unroll
            for (int j = 0; j < 8; ++j) {
                float t = d[0][j];
#pragma unroll
                for (int rr = 1; rr < NR; ++rr) t = lane == rr ? d[rr][j] : t;
                dd[j] = t;
            }
            *(f32x4*)(GAB + (size_t)(row0 + lane) * 8) = (f32x4){dd[0], dd[1], dd[2], dd[3]}; *(f32x4*)(GAB + (size_t)(row0 + lane) * 8 + 4) = (f32x4){dd[4], dd[5], dd[6], dd[7]};
        }
    }
}
template <int MODE> __device__ __forceinline__ void phase_norm(const Params& p, int l, float* L) {
    const int tid = threadIdx.x, wave = tid >> 6, lane = tid & 63;
    const float* nw = MODE == 0 ? p.in[9] + l * 1024 : (MODE == 1 ? p.in[20] + l * 1024 : p.in[23]);
    if (MODE == 0) {
        const float* win = p.in[10] + (size_t)l * 1024 * 6152 + 3584;
        for (int i = tid; i < 8192; i += 512) { const int k = i >> 3, j = i & 7; L[j * 1024 + k] = win[(size_t)k * 6152 + j]; }
        __syncthreads();
    }
    f32x4 nw4[4];
#pragma unroll
    for (int i = 0; i < 4; ++i) nw4[i] = *(const f32x4*)(nw + i * 256 + lane * 4);
    const int gw = blockIdx.x * 8 + wave, nwv = gridDim.x * 8;
    for (int task = gw; task < NPROW / 4; task += nwv) norm_task<MODE, 4>(p, l, L, task * 4, nw4, lane);
    for (int t = gw; t < MROWS - NPROW; t += nwv) norm_task<MODE, 1>(p, l, L, NPROW + t, nw4, lane);
    __syncthreads();
}

__device__ __forceinline__ void phase_post(const Params& p, int l) {
    const int tid = threadIdx.x, wave = tid >> 6, lane = tid & 63;
    bf16_t* seg = (bf16_t*)(p.ws + WS_SEG);
    const bool wgt = gridDim.x == 256;
    const int b_ = (int)blockIdx.x;
    const int it0 = wgt ? (b_ >= 32 ? b_ - 32 : 2016 + b_) : b_, its = wgt ? (b_ >= 32 ? 224 : 32) : (int)gridDim.x, itn = wgt ? (b_ >= 32 ? 2016 : 2112) : 2112;
    for (int it = it0; it < itn; it += its) {
        const int task = it * 8 + wave;
        const int br = task & 1, row0 = (task >> 1) * 4;
        bf16_t* O = (br ? (bf16_t*)(p.ws + WS_E0) + 2 * SEGSZ : seg + 2 * SEGSZ) + (size_t)row0 * 512 + lane * 8;
        const bf16_t* Gt = seg + (br ? 7 : 3) * SEGSZ + (size_t)row0 * 512 + lane * 8;
        const float* nw = (br ? p.in[16] : p.in[12]) + l * 128 + (lane & 15) * 8;
        u32x4 ow[4], gw[4];
#pragma unroll
        for (int rr = 0; rr < 4; ++rr) { ow[rr] = *(const u32x4*)(O + rr * 512); gw[rr] = *(const u32x4*)(Gt + rr * 512); }
        float nwv[8];
#pragma unroll
        for (int j = 0; j < 8; ++j) nwv[j] = nw[j];
#pragma unroll
        for (int rr = 0; rr < 4; ++rr) {
            float o[8], g[8]; unpack8(ow[rr], o); unpack8(gw[rr], g);
            float ss = 0.f;
#pragma unroll
            for (int j = 0; j < 8; ++j) ss += o[j] * o[j];
            ss += __shfl_xor(ss, 1); ss += __shfl_xor(ss, 2); ss += __shfl_xor(ss, 4); ss += __shfl_xor(ss, 8);
            const float rstd = rsqrtf(ss * (1.0f / 128.0f) + 1e-6f);
#pragma unroll
            for (int j = 0; j < 8; ++j) o[j] = (o[j] * rstd * nwv[j]) * silu_(g[j]);
            *(u32x4*)(O + rr * 512) = pack8(o);
        }
    }
}

typedef float f32x16 __attribute__((ext_vector_type(16)));
typedef float f32x2_t __attribute__((ext_vector_type(2)));
typedef __bf16 bf16x2_t __attribute__((ext_vector_type(2)));
typedef unsigned u32x2 __attribute__((ext_vector_type(2)));
typedef short s16x4 __attribute__((ext_vector_type(4)));
#define MFMA32(a, b, c) __builtin_amdgcn_mfma_f32_32x32x16_bf16((a), (b), (c), 0, 0, 0)
__device__ __forceinline__ unsigned cvt2(float lo, float hi) { const f32x2_t v = {lo, hi}; return __builtin_bit_cast(unsigned, __builtin_convertvector(v, bf16x2_t)); }
__device__ __forceinline__ u32x4 pack8c(const float* f) { u32x4 w; w.x = cvt2(f[0], f[1]); w.y = cvt2(f[2], f[3]); w.z = cvt2(f[4], f[5]); w.w = cvt2(f[6], f[7]); return w; }
__device__ __forceinline__ bf16_t cvt1(float x) { return (bf16_t)(cvt2(x, 0.0f) & 0xffffu); }
__device__ __forceinline__ unsigned xrow(unsigned row) { return ((row & 3u) << 2) | ((row >> 2) & 3u); }
__device__ __forceinline__ unsigned offb(unsigned row, unsigned ch) { return 256u * row + 16u * (ch ^ xrow(row)); }
__device__ __forceinline__ unsigned swap23(unsigned c) { return (c & ~12u) | ((c & 4u) << 1) | ((c & 8u) >> 1); }
__device__ __forceinline__ int crow(int reg, int h) { return (reg & 3) + 8 * (reg >> 2) + 4 * h; }
__device__ __forceinline__ unsigned tr_addr(unsigned lane, unsigned c, unsigned ks, unsigned t) {
    const unsigned h = lane >> 5, blk = (lane >> 4) & 1, q = (lane & 15) >> 2, pp = lane & 3;
    return offb(16 * ks + 8 * h + 4 * t + q, 4 * c + 2 * blk + (pp >> 1)) + 8 * (pp & 1);
}
__device__ __forceinline__ unsigned tr_addr_perm(unsigned lane, unsigned c, unsigned ks, unsigned t) {
    const unsigned h = lane >> 5, blk = (lane >> 4) & 1, q = (lane & 15) >> 2, pp = lane & 3;
    return offb(16 * ks + 8 * t + 4 * h + q, 4 * c + 2 * blk + (pp >> 1)) + 8 * (pp & 1);
}
__device__ __forceinline__ bf16x8 tr_pair(unsigned a0, unsigned a1) {
    s16x4 lo, hi;
    asm volatile("ds_read_b64_tr_b16 %0, %2\n\tds_read_b64_tr_b16 %1, %3\n\ts_waitcnt lgkmcnt(0)" : "=&v"(lo), "=&v"(hi) : "v"(a0), "v"(a1) : "memory");
    return __builtin_shufflevector(lo, hi, 0, 1, 2, 3, 4, 5, 6, 7);
}
struct Frag4 { bf16x8 f[4]; };
__device__ __forceinline__ Frag4 tr_quad(unsigned a0, unsigned a1, unsigned a2, unsigned a3, unsigned a4, unsigned a5, unsigned a6, unsigned a7) {
    s16x4 v0, v1, v2, v3, v4, v5, v6, v7;
    asm volatile("ds_read_b64_tr_b16 %0, %8\n\tds_read_b64_tr_b16 %1, %9\n\tds_read_b64_tr_b16 %2, %10\n\tds_read_b64_tr_b16 %3, %11\n\t"
                 "ds_read_b64_tr_b16 %4, %12\n\tds_read_b64_tr_b16 %5, %13\n\tds_read_b64_tr_b16 %6, %14\n\tds_read_b64_tr_b16 %7, %15\n\ts_waitcnt lgkmcnt(0)"
                 : "=&v"(v0), "=&v"(v1), "=&v"(v2), "=&v"(v3), "=&v"(v4), "=&v"(v5), "=&v"(v6), "=&v"(v7)
                 : "v"(a0), "v"(a1), "v"(a2), "v"(a3), "v"(a4), "v"(a5), "v"(a6), "v"(a7) : "memory");
    Frag4 r;
    r.f[0] = __builtin_shufflevector(v0, v1, 0, 1, 2, 3, 4, 5, 6, 7); r.f[1] = __builtin_shufflevector(v2, v3, 0, 1, 2, 3, 4, 5, 6, 7);
    r.f[2] = __builtin_shufflevector(v4, v5, 0, 1, 2, 3, 4, 5, 6, 7); r.f[3] = __builtin_shufflevector(v6, v7, 0, 1, 2, 3, 4, 5, 6, 7);
    return r;
}
__device__ __forceinline__ bf16x8 pack_step(const f32x16& x, const int s) {
    u32x4 w; w.x = cvt2(x[8 * s], x[8 * s + 1]); w.y = cvt2(x[8 * s + 2], x[8 * s + 3]); w.z = cvt2(x[8 * s + 4], x[8 * s + 5]); w.w = cvt2(x[8 * s + 6], x[8 * s + 7]);
    return __builtin_bit_cast(bf16x8, w);
}
__device__ __forceinline__ f32x16 zero16() { f32x16 z; for (int i = 0; i < 16; ++i) z[i] = 0.f; return z; }

#define LBAR() do { asm volatile("s_waitcnt lgkmcnt(0)" ::: "memory"); __builtin_amdgcn_s_barrier(); asm volatile("" ::: "memory"); } while (0)

__device__ __forceinline__ void phase_conv(const Params& p, int l, float* L) {
    const int tid = threadIdx.x, wave = tid >> 6, lane = tid & 63;
    for (int i = tid; i < 6144; i += 512) L[i] = p.in[13][(size_t)l * 6144 + i];
    __syncthreads();
    const bf16_t* seg = (const bf16_t*)(p.ws + WS_SEG); bf16_t* E = (bf16_t*)(p.ws + WS_E0);
    for (int task = blockIdx.x * 8 + wave; task < 3 * (MROWS / 8); task += gridDim.x * 8) {
        const int rb = task / 3, part = task - rb * 3, row0 = rb * 8;
        const int grp = row0 >= NPROW, t0 = grp ? ((row0 - NPROW) & 31) : (row0 & 2047), T = grp ? 32 : 2048, seqi = grp ? ((row0 - NPROW) >> 5) : (row0 >> 11);
        const bf16_t* src = seg + (size_t)(4 + part) * SEGSZ + (size_t)row0 * 512 + lane * 8;
        const int ch = part * 512 + lane * 8;
        float x[11][8];
#pragma unroll
        for (int i = 0; i < 8; ++i) unpack8(*(const u32x4*)(src + (size_t)i * 512), x[3 + i]);
        if (t0 > 0) {
#pragma unroll
            for (int j = 1; j <= 3; ++j) unpack8(*(const u32x4*)(src - (size_t)j * 512), x[3 - j]);
        } else if (grp) {
#pragma unroll
            for (int j = 0; j < 3; ++j) {
                const float* sc = p.in[4] + (size_t)((l * 32 + seqi) * 3 + j) * 1536 + ch;
                const f32x4 a = *(const f32x4*)sc, b = *(const f32x4*)(sc + 4);
                x[j][0] = a[0]; x[j][1] = a[1]; x[j][2] = a[2]; x[j][3] = a[3]; x[j][4] = b[0]; x[j][5] = b[1]; x[j][6] = b[2]; x[j][7] = b[3];
            }
        } else {
#pragma unroll
            for (int j = 0; j < 3; ++j)
#pragma unroll
                for (int e = 0; e < 8; ++e) x[j][e] = 0.f;
        }
        float cw[4][8];
#pragma unroll
        for (int j = 0; j < 4; ++j)
#pragma unroll
            for (int e = 0; e < 8; ++e) cw[j][e] = L[j * 1536 + ch + e];
#pragma unroll
        for (int i = 0; i < 8; ++i) {
            float y[8]; float ss = 0.f;
#pragma unroll
            for (int e = 0; e < 8; ++e) {
                float a = x[i][e] * cw[0][e] + x[i + 1][e] * cw[1][e] + x[i + 2][e] * cw[2][e] + x[i + 3][e] * cw[3][e];
                a = silu_(a); y[e] = a; ss += a * a;
            }
            if (part < 2) {
                ss += __shfl_xor(ss, 1); ss += __shfl_xor(ss, 2); ss += __shfl_xor(ss, 4); ss += __shfl_xor(ss, 8);
                const float sc = rsqrtf(ss + 1e-6f) * (part == 0 ? 0.08838834764831845f : 1.0f);
#pragma unroll
                for (int e = 0; e < 8; ++e) y[e] *= sc;
            }
            *(u32x4*)(E + (size_t)part * SEGSZ + (size_t)(row0 + i) * 512 + lane * 8) = pack8(y);
            const int t = t0 + i;
            if (t >= T - 3) {
                float* co = p.out + (grp ? O_CVS + (size_t)((l * 32 + seqi) * 3 + (t - (T - 3))) * 1536 : O_CVP + (size_t)((l * 16 + seqi) * 3 + (t - (T - 3))) * 1536) + ch;
                *(f32x4*)co = (f32x4){x[3 + i][0], x[3 + i][1], x[3 + i][2], x[3 + i][3]}; *(f32x4*)(co + 4) = (f32x4){x[3 + i][4], x[3 + i][5], x[3 + i][6], x[3 + i][7]};
            }
        }
    }
    __syncthreads();
}

__device__ __forceinline__ unsigned char* slice_ptr(bf16_t* segbase, int gc, int h) { return (unsigned char*)(segbase + (size_t)gc * 32 * 512 + h * 128); }
__device__ __forceinline__ void store_cfrag_global(unsigned char* sl, const f32x16& v, int c, int r, int hh) {
#pragma unroll
    for (int g = 0; g < 4; ++g) {
        const unsigned off = (unsigned)((((c * 4 + g) * 2 + hh) * 32 + r) * 8);
        u32x2 w; w.x = cvt2(v[4 * g], v[4 * g + 1]); w.y = cvt2(v[4 * g + 2], v[4 * g + 3]);
        *(u32x2*)(sl + (size_t)(off >> 8) * 1024 + (off & 255u)) = w;
    }
}

__device__ __forceinline__ void pair_prep(const Params& p, int l, int gc, int h, unsigned char* shm, unsigned ldsb, const u32x4 rq, const u32x4 rk, const u32x4 rv, const u32x4 hrq, const u32x4 hrf, const u32x4 hrv, const u32x4 halo, const float gab_a, const float gab_b, const float (&lbv)[8]) {
    int tid = threadIdx.x; asm volatile("" : "+v"(tid));
    const int wave = __builtin_amdgcn_readfirstlane(tid >> 6), lane = tid & 63, r = lane & 31, hh = lane >> 5, tok = tid >> 4, c8 = tid & 15;
    unsigned char* QT = shm; unsigned char* KT = shm + 8192; unsigned char* KB = shm + 16384; unsigned char* VB = shm + 24576;
    float* QGF = (float*)(shm + 32768); float* MM = (float*)(shm + 49152); bf16_t* QKM = (bf16_t*)(shm + 53248); bf16_t* TM = (bf16_t*)(shm + 55296);
    unsigned char* WI = shm + 57344; unsigned char* UI = shm + 65536; float* LA = (float*)(shm + 73728); float* BETA = LA + 32; float* GS = LA + 64;
    bf16_t* seg = (bf16_t*)(p.ws + WS_SEG); bf16_t* E = (bf16_t*)(p.ws + WS_E0);
    unsigned char* sQ = slice_ptr(E, gc, h); unsigned char* sK = slice_ptr(E + SEGSZ, gc, h); unsigned char* sV = slice_ptr(E + 2 * SEGSZ, gc, h);
    unsigned char* sW = slice_ptr(seg + 4 * SEGSZ, gc, h); unsigned char* sOI = slice_ptr(seg + 5 * SEGSZ, gc, h);
    bf16_t* RW = (bf16_t*)(shm + 32768); const float* CW = (const float*)(shm + 120832);
    {
        *(u32x4*)(RW + (3 + tok) * 384 + c8 * 8) = rq; *(u32x4*)(RW + (3 + tok) * 384 + 128 + c8 * 8) = rk; *(u32x4*)(RW + (3 + tok) * 384 + 256 + c8 * 8) = rv;
        if (tid < 144) { const int hr = tid / 48, cc = tid - hr * 48; *(u32x4*)(RW + hr * 384 + (cc >> 4) * 128 + (cc & 15) * 8) = halo; }
        if ((gc >= 1024 || (gc & 63) == 63) && tok >= 29) {
            float* co = p.out + (gc >= 1024 ? O_CVS + (size_t)((l * 32 + (gc - 1024)) * 3 + (tok - 29)) * 1536 : O_CVP + (size_t)((l * 16 + (gc >> 6)) * 3 + (tok - 29)) * 1536) + h * 128 + c8 * 8;
            float t8[8];
            unpack8(rq, t8); *(f32x4*)co = (f32x4){t8[0], t8[1], t8[2], t8[3]}; *(f32x4*)(co + 4) = (f32x4){t8[4], t8[5], t8[6], t8[7]};
            unpack8(rk, t8); *(f32x4*)(co + 512) = (f32x4){t8[0], t8[1], t8[2], t8[3]}; *(f32x4*)(co + 516) = (f32x4){t8[4], t8[5], t8[6], t8[7]};
            unpack8(rv, t8); *(f32x4*)(co + 1024) = (f32x4){t8[0], t8[1], t8[2], t8[3]}; *(f32x4*)(co + 1028) = (f32x4){t8[4], t8[5], t8[6], t8[7]};
        }
    }
    float q[8], k[8], v[8];
    if (tid < 32) {
        const float xa = gab_a + p.in[15][l * 4 + h], sp_ = xa > 20.0f ? xa : log1pf(__expf(xa));
        LA[tid] = -__expf(p.in[14][l * 4 + h]) * sp_; BETA[tid] = sigm(gab_b);
    }
    float* hLF = (float*)(shm + 75776); float* hPT = (float*)(shm + 92160);
    unsigned char* hQT = shm + 94208; unsigned char* hKT = shm + 102400; unsigned char* hVT = shm + 110592; bf16_t* hAM = (bf16_t*)(shm + 118784);
    bf16_t* hseg = (bf16_t*)(p.ws + WS_SEG);
    unsigned char* hsHQ = slice_ptr(hseg, gc, h); unsigned char* hsHF = slice_ptr(hseg + SEGSZ, gc, h); unsigned char* hsHI = slice_ptr(hseg + 2 * SEGSZ, gc, h); unsigned char* hsOI = slice_ptr(hseg + 6 * SEGSZ, gc, h);
    float* hDG = (float*)(p.ws + WS_DG) + (size_t)(gc * 4 + h) * 128;
    float hq[8], hf[8];
    unpack8(hrq, hq); unpack8(hrf, hf);
    {
        float lf[8];
#pragma unroll
        for (int j = 0; j < 8; ++j) { const float lb = lbv[j]; hf[j] = lb + (1.0f - lb) * sigm(hf[j]); lf[j] = __logf(hf[j]); }
        *(f32x4*)(hLF + tok * 128 + c8 * 8) = (f32x4){lf[0], lf[1], lf[2], lf[3]}; *(f32x4*)(hLF + tok * 128 + c8 * 8 + 4) = (f32x4){lf[4], lf[5], lf[6], lf[7]};
    }
    LBAR();
    {
#pragma unroll
        for (int part = 0; part < 3; ++part) {
            float y[8]; float ss = 0.f;
            float x0[8], x1[8], x2[8], x3[8];
            unpack8(*(const u32x4*)(RW + (tok) * 384 + part * 128 + c8 * 8), x0); unpack8(*(const u32x4*)(RW + (tok + 1) * 384 + part * 128 + c8 * 8), x1);
            unpack8(*(const u32x4*)(RW + (tok + 2) * 384 + part * 128 + c8 * 8), x2); unpack8(*(const u32x4*)(RW + (tok + 3) * 384 + part * 128 + c8 * 8), x3);
            const float* cwp = CW + part * 128 + c8 * 8;
#pragma unroll
            for (int e = 0; e < 8; ++e) {
                float a = x0[e] * cwp[e] + x1[e] * cwp[384 + e] + x2[e] * cwp[768 + e] + x3[e] * cwp[1152 + e];
                a = silu_(a); y[e] = a; ss += a * a;
            }
            if (part < 2) {
                ss += __shfl_xor(ss, 1); ss += __shfl_xor(ss, 2); ss += __shfl_xor(ss, 4); ss += __shfl_xor(ss, 8);
                const float sc = rsqrtf(ss + 1e-6f) * (part == 0 ? 0.08838834764831845f : 1.0f);
#pragma unroll
                for (int e = 0; e < 8; ++e) y[e] *= sc;
            }
#pragma unroll
            for (int e = 0; e < 8; ++e) { if (part == 0) q[e] = y[e]; else if (part == 1) k[e] = y[e]; else v[e] = y[e]; }
        }
    }
    if (wave == 0) {
        float g = LA[r];
#pragma unroll
        for (int d = 1; d < 32; d <<= 1) { const float t = __shfl_up(g, d); if (r >= d) g += t; }
        if (lane < 32) GS[lane] = g;
    }
    {
        const int d = tid & 127, part = tid >> 7; float run = 0.f;
#pragma unroll
        for (int i = 0; i < 8; ++i) { run += hLF[(part * 8 + i) * 128 + d]; hLF[(part * 8 + i) * 128 + d] = run; }
        hPT[part * 128 + d] = run;
    }
    LBAR();
    {
        const float g = GS[tok], gL = GS[31], be = BETA[tok], eg = __expf(g), ekd = __expf(gL - g);
        float t8[8];
        *(u32x4*)(QT + offb(tok, c8)) = pack8c(q); *(u32x4*)(KT + offb(tok, c8)) = pack8c(k);
#pragma unroll
        for (int j = 0; j < 8; ++j) t8[j] = be * eg * k[j];
        *(u32x4*)(KB + offb(tok, c8)) = pack8c(t8);
#pragma unroll
        for (int j = 0; j < 8; ++j) t8[j] = be * v[j];
        *(u32x4*)(VB + offb(tok, c8)) = pack8c(t8);
        *(f32x4*)(QGF + tok * 128 + c8 * 8) = (f32x4){q[0] * eg, q[1] * eg, q[2] * eg, q[3] * eg}; *(f32x4*)(QGF + tok * 128 + c8 * 8 + 4) = (f32x4){q[4] * eg, q[5] * eg, q[6] * eg, q[7] * eg};
#pragma unroll
        for (int j = 0; j < 8; ++j) t8[j] = k[j] * ekd;
        *(u32x4*)(sK + (size_t)tok * 1024 + 16u * ((unsigned)c8 ^ xrow(tok))) = pack8c(t8);
        if (tid == 0) ((float*)(p.ws + WS_AL))[gc * 4 + h] = __expf(gL);
    }
    {
        float qg[8], qt[8], kt[8], kd[8];
        const int tp = tok >> 3;
        float P0[8], P1[8], P2[8], GT[8], GR[8], GE[8];
        {
            const int d0 = c8 * 8;
#define LD8_(dst, ptr) do { const f32x4 a_ = *(const f32x4*)(ptr), b_ = *(const f32x4*)((ptr) + 4); dst[0] = a_[0]; dst[1] = a_[1]; dst[2] = a_[2]; dst[3] = a_[3]; dst[4] = b_[0]; dst[5] = b_[1]; dst[6] = b_[2]; dst[7] = b_[3]; } while (0)
            LD8_(P0, hPT + d0); LD8_(P1, hPT + 128 + d0); LD8_(P2, hPT + 256 + d0); LD8_(GT, hLF + tok * 128 + d0); LD8_(GR, hLF + 15 * 128 + d0); LD8_(GE, hLF + 31 * 128 + d0);
#undef LD8_
        }
#pragma unroll
        for (int j = 0; j < 8; ++j) {
            const int d = c8 * 8 + j;
            const float p0 = P0[j], p1 = P1[j], p2 = P2[j];
            const float base = tp == 0 ? 0.f : (tp == 1 ? p0 : (tp == 2 ? p0 + p1 : p0 + p1 + p2));
            const float G = GT[j] + base, Gref = GR[j] + p0, GL = GE[j] + p0 + p1 + p2;
            const float kk = 1.0f - hf[j], qs = hq[j] * 0.08838834764831845f;
            qg[j] = qs * __expf(G); qt[j] = qs * __expf(G - Gref); kt[j] = kk * __expf(Gref - G); kd[j] = kk * __expf(GL - G);
            if (tok == 0) hDG[d] = __expf(GL);
        }
        *(u32x4*)(hQT + offb(tok, c8)) = pack8c(qt); *(u32x4*)(hKT + offb(tok, c8)) = pack8c(kt); *(u32x4*)(hVT + offb(tok, c8)) = hrv;
        const unsigned xr = xrow(tok), chA = (unsigned)(c8 & ~1), chB = chA | 1u, eo = (unsigned)(c8 & 1) * 8u;
        u32x2 lo, hi; lo.x = cvt2(qg[0], qg[1]); lo.y = cvt2(qg[2], qg[3]); hi.x = cvt2(qg[4], qg[5]); hi.y = cvt2(qg[6], qg[7]);
        *(u32x2*)(hsHQ + (size_t)tok * 1024 + 16u * (chA ^ xr) + eo) = lo; *(u32x2*)(hsHQ + (size_t)tok * 1024 + 16u * (chB ^ xr) + eo) = hi;
        *(u32x4*)(hsHF + (size_t)tok * 1024 + 16u * ((unsigned)c8 ^ xr)) = pack8c(kd);
        *(u32x4*)(hsHI + (size_t)tok * 1024 + 16u * ((unsigned)c8 ^ xr)) = hrv;
    }
    LBAR();
    if (wave < 2) {
        f32x16 acc = zero16();
        {
            bf16x8 fb[8], fa[8];
#pragma unroll
            for (int s = 0; s < 8; ++s) { fb[s] = *(const bf16x8*)(KT + offb(r, 2 * s + hh)); fa[s] = *(const bf16x8*)((wave == 0 ? KT : QT) + offb(r, 2 * s + hh)); }
            __builtin_amdgcn_sched_barrier(0);
#pragma unroll
            for (int s = 0; s < 8; ++s) acc = MFMA32(fa[s], fb[s], acc);
        }
        const float gs = GS[r];
#pragma unroll
        for (int reg = 0; reg < 16; ++reg) {
            const int t = crow(reg, hh); const float dec = __expf(GS[t] - gs);
            if (wave == 0) MM[t * 32 + r] = r < t ? BETA[t] * dec * acc[reg] : 0.0f;
            else QKM[t * 32 + r] = cvt1(r <= t ? dec * acc[reg] : 0.0f);
        }
    }
    if (wave == 2) {
        f32x16 acc = zero16();
        {
            bf16x8 fa[8], fb[8];
#pragma unroll
            for (int s = 0; s < 8; ++s) { fa[s] = *(const bf16x8*)(hQT + offb(r, 2 * s + hh)); fb[s] = *(const bf16x8*)(hKT + offb(r, 2 * s + hh)); }
            __builtin_amdgcn_sched_barrier(0);
#pragma unroll
            for (int s = 0; s < 8; ++s) acc = MFMA32(fa[s], fb[s], acc);
        }
#pragma unroll
        for (int reg = 0; reg < 16; ++reg) { const int t = crow(reg, hh); hAM[t * 32 + r] = cvt1(r <= t ? acc[reg] : 0.0f); }
    }
    LBAR();
    if (wave == 0) {
        float Tc[32];
#pragma unroll
        for (int t = 0; t < 32; ++t) Tc[t] = 0.f;
#pragma unroll
        for (int t = 0; t < 32; ++t) {
            float a0 = (t == r) ? 1.0f : 0.0f, a1 = 0.f, a2 = 0.f, a3 = 0.f;
#pragma unroll
            for (int s4 = 0; s4 < t; s4 += 4) {
                const f32x4 m = *(const f32x4*)(MM + t * 32 + s4);
                a0 -= m[0] * Tc[s4]; a1 -= m[1] * Tc[s4 + 1]; a2 -= m[2] * Tc[s4 + 2]; a3 -= m[3] * Tc[s4 + 3];
            }
            Tc[t] = (a0 + a1) + (a2 + a3);
        }
        if (hh == 0) {
#pragma unroll
            for (int t = 0; t < 32; ++t) TM[t * 32 + r] = cvt1(Tc[t]);
        }
    }
    if (wave >= 4) {
        const int c = wave - 4; f32x16 acc = zero16();
#pragma unroll
        for (int ks = 0; ks < 2; ++ks) {
            const bf16x8 a = *(const bf16x8*)((const unsigned char*)hAM + r * 64 + ks * 32 + hh * 16);
            const bf16x8 b = tr_pair(ldsb + 110592 + tr_addr(lane, c, ks, 0), ldsb + 110592 + tr_addr(lane, c, ks, 1));
            acc = MFMA32(a, b, acc);
        }
        store_cfrag_global(hsOI, acc, c, r, hh);
    }
    LBAR();
    {
        const int c = wave & 3; const unsigned img = wave < 4 ? 16384u : 24576u;
        f32x16 acc = zero16();
#pragma unroll
        for (int ks = 0; ks < 2; ++ks) {
            const bf16x8 a = *(const bf16x8*)((const unsigned char*)TM + r * 64 + ks * 32 + hh * 16);
            const bf16x8 b = tr_pair(ldsb + img + tr_addr(lane, c, ks, 0), ldsb + img + tr_addr(lane, c, ks, 1));
            acc = MFMA32(a, b, acc);
        }
        const unsigned col = 32u * c + r;
        if (wave < 4) {
            const unsigned pos = swap23(col);
#pragma unroll
            for (int reg = 0; reg < 16; ++reg) {
                const unsigned t = (unsigned)crow(reg, hh); const bf16_t w = cvt1(acc[reg]);
                *(bf16_t*)(WI + offb(t, col >> 3) + 2u * (col & 7u)) = w;
                *(bf16_t*)(sW + (size_t)t * 1024 + 16u * ((pos >> 3) ^ xrow(t)) + 2u * (pos & 7u)) = w;
            }
        } else {
#pragma unroll
            for (int reg = 0; reg < 16; ++reg) { const unsigned t = (unsigned)crow(reg, hh); *(bf16_t*)(UI + offb(t, col >> 3) + 2u * (col & 7u)) = cvt1(acc[reg]); }
            store_cfrag_global(sV, acc, c, r, hh);
        }
    }
    LBAR();
    {
        const int c = wave & 3; const unsigned img = wave < 4 ? 57344u : 65536u;
        f32x16 acc = zero16();
#pragma unroll
        for (int ks = 0; ks < 2; ++ks) {
            const bf16x8 a = *(const bf16x8*)((const unsigned char*)QKM + r * 64 + ks * 32 + hh * 16);
            const bf16x8 b = tr_pair(ldsb + img + tr_addr(lane, c, ks, 0), ldsb + img + tr_addr(lane, c, ks, 1));
            acc = MFMA32(a, b, acc);
        }
        if (wave < 4) {
            const unsigned col = 32u * c + r, pos = swap23(col);
#pragma unroll
            for (int reg = 0; reg < 16; ++reg) {
                const unsigned t = (unsigned)crow(reg, hh);
                *(bf16_t*)(sQ + (size_t)t * 1024 + 16u * ((pos >> 3) ^ xrow(t)) + 2u * (pos & 7u)) = cvt1(QGF[t * 128 + col] - acc[reg]);
            }
        } else store_cfrag_global(sOI, acc, c, r, hh);
    }
    LBAR();
}

__device__ __forceinline__ void phase_prep(const Params& p, int l, unsigned char* shm) {
    const unsigned ldsb = (unsigned)(size_t)shm;
    const int tid = threadIdx.x, tok = tid >> 4, c8 = tid & 15;
    bf16_t* seg = (bf16_t*)(p.ws + WS_SEG); bf16_t* E = (bf16_t*)(p.ws + WS_E0);
    u32x4 n0 = {0u, 0u, 0u, 0u}, n1 = n0, n2 = n0, n3 = n0, n4 = n0, n5 = n0, n6 = n0; float na = 0.f, nb = 0.f;
    float lbv[8];
#pragma unroll
    for (int j = 0; j < 8; ++j) lbv[j] = ((const float*)(p.ws + WS_LB))[l * 512 + (blockIdx.x & 3) * 128 + c8 * 8 + j];
    {
        float* CWs = (float*)(shm + 120832); const int hfix = blockIdx.x & 3;
        for (int idx = tid; idx < 1536; idx += 512) { const int j = idx / 384, ch = idx - j * 384; CWs[idx] = p.in[13][(size_t)(l * 4 + j) * 1536 + (ch >> 7) * 512 + hfix * 128 + (ch & 127)]; }
        __syncthreads();
    }
#define PREP_LOAD(u_) do { const int i_ = (u_); \
        const unsigned char* s_ = slice_ptr(seg + 4 * SEGSZ, i_ >> 2, i_ & 3) + (size_t)tok * 1024 + c8 * 16; \
        const unsigned char* t_ = slice_ptr(seg, i_ >> 2, i_ & 3) + (size_t)tok * 1024 + c8 * 16; \
        n0 = *(const u32x4*)s_; n1 = *(const u32x4*)(s_ + SEGSZ * 2); n2 = *(const u32x4*)(s_ + SEGSZ * 4); \
        n3 = *(const u32x4*)t_; n4 = *(const u32x4*)(t_ + SEGSZ * 2); n5 = *(const u32x4*)(t_ + SEGSZ * 4); \
        n6 = (u32x4){0u, 0u, 0u, 0u}; \
        if (tid < 32) { const float* gab_ = (const float*)(p.ws + WS_GAB) + (size_t)((i_ >> 2) * 32 + tid) * 8; na = gab_[i_ & 3]; nb = gab_[4 + (i_ & 3)]; } \
        if (tid < 144) { const int g_ = i_ >> 2, h_ = i_ & 3, hr_ = tid / 48, cc_ = tid - hr_ * 48, pt_ = cc_ >> 4, c8h_ = cc_ & 15; \
            if (g_ >= 1024) { const float* sc_ = p.in[4] + (size_t)((l * 32 + (g_ - 1024)) * 3 + hr_) * 1536 + pt_ * 512 + h_ * 128 + c8h_ * 8; \
                const f32x4 a_ = *(const f32x4*)sc_, b_ = *(const f32x4*)(sc_ + 4); float t8_[8] = {a_[0], a_[1], a_[2], a_[3], b_[0], b_[1], b_[2], b_[3]}; n6 = pack8(t8_); } \
            else if ((g_ & 63) != 0) n6 = *(const u32x4*)((const bf16_t*)(p.ws + WS_HALO) + ((size_t)(g_ - 1) * 3 + hr_) * 1536 + pt_ * 512 + h_ * 128 + c8h_ * 8); } } while (0)
    int u = blockIdx.x;
    if (u < 4224) PREP_LOAD(u);
    for (; u < 4224; u += gridDim.x) {
        const u32x4 c0 = n0, c1 = n1, c2 = n2, c3 = n3, c4 = n4, c5 = n5, c6 = n6; const float ca = na, cb = nb;
        const int un = u + (int)gridDim.x;
        if (un < 4224) PREP_LOAD(un);
        pair_prep(p, l, u >> 2, u & 3, shm, ldsb, c0, c1, c2, c3, c4, c5, c6, ca, cb, lbv);
    }
#undef PREP_LOAD
}

constexpr int STG = 41472;
template <int KIND> __device__ __forceinline__ void scan_chain(const Params& p, int l, int grp, int bseq, int h, unsigned char* shm, unsigned ldsb) {
    const int tid = threadIdx.x, wave = tid >> 6, lane = tid & 63, r = lane & 31, hh = lane >> 5, c = wave & 3;
    const int nch = grp ? 1 : 64, gc0 = grp ? 1024 + bseq : bseq * 64;
    bf16_t* seg = (bf16_t*)(p.ws + WS_SEG); bf16_t* E = (bf16_t*)(p.ws + WS_E0);
    const bf16_t* src0 = KIND ? seg : E; const bf16_t* src1 = KIND ? seg + SEGSZ : E + SEGSZ; const bf16_t* src2 = KIND ? seg + 2 * SEGSZ : E + 2 * SEGSZ;
    const bf16_t* src3 = KIND ? seg + 6 * SEGSZ : seg + 5 * SEGSZ; const bf16_t* src4 = seg + 4 * SEGSZ;
    bf16_t* odst = KIND ? seg + 2 * SEGSZ : E + 2 * SEGSZ;
    const float* XT = KIND ? (const float*)(p.ws + WS_DG) : (const float*)(p.ws + WS_AL);
    f32x16 S[4];
    if (wave < 4) {
        if (grp) {
            const float* s0 = p.in[KIND ? 2 : 3] + (size_t)((l * 32 + bseq) * 4 + h) * 16384 + 32 * c + r;
#pragma unroll
            for (int i = 0; i < 4; ++i)
#pragma unroll
                for (int reg = 0; reg < 16; ++reg) S[i][reg] = s0[(32 * i + crow(reg, hh)) * 128];
        } else {
#pragma unroll
            for (int i = 0; i < 4; ++i) S[i] = zero16();
        }
    }
    u32x4 w_[KIND ? 8 : 10]; f32x4 wx_ = {0.f, 0.f, 0.f, 0.f};
    const int lt = tid - 256;
#define SCAN_ISSUE(gc_) do { \
        const size_t so_ = (size_t)(gc_) * 32 * 512 + h * 128; \
        _Pragma("unroll") for (int i_ = 0; i_ < 2; ++i_) { const int idx_ = lt + 256 * i_, row_ = idx_ >> 4, ch_ = idx_ & 15; const size_t o_ = so_ + (size_t)row_ * 512 + ch_ * 8; \
            w_[i_] = *(const u32x4*)(src0 + o_); w_[2 + i_] = *(const u32x4*)(src1 + o_); w_[4 + i_] = *(const u32x4*)(src2 + o_); w_[6 + i_] = *(const u32x4*)(src3 + o_); \
            if (!KIND) w_[(KIND ? 0 : 8) + i_] = *(const u32x4*)(src4 + o_); } \
        if (KIND) { if (lt < 32) wx_ = *(const f32x4*)(XT + (size_t)((gc_) * 4 + h) * 128 + lt * 4); } \
        else { if (lt == 0) wx_[0] = XT[(gc_) * 4 + h]; } \
    } while (0)
#define SCAN_WRITE(stage_) do { \
        unsigned char* st_ = shm + (stage_) * STG; \
        _Pragma("unroll") for (int i_ = 0; i_ < 2; ++i_) { const int idx_ = lt + 256 * i_, row_ = idx_ >> 4, ch_ = idx_ & 15; unsigned char* d_ = st_ + row_ * 256 + ch_ * 16; \
            *(u32x4*)d_ = w_[i_]; *(u32x4*)(d_ + 8192) = w_[2 + i_]; *(u32x4*)(d_ + 16384) = w_[4 + i_]; *(u32x4*)(d_ + 24576) = w_[6 + i_]; \
            if (!KIND) *(u32x4*)(d_ + 32768) = w_[(KIND ? 0 : 8) + i_]; } \
        if (KIND) { if (lt < 32) *(f32x4*)(st_ + 40960 + lt * 16) = wx_; } \
        else { if (lt == 0) *(float*)(st_ + 40960) = wx_[0]; } \
    } while (0)
    if (wave >= 4) { SCAN_ISSUE(gc0); SCAN_WRITE(0); if (nch > 1) SCAN_ISSUE(gc0 + 1); }
    __syncthreads();
    for (int ci = 0; ci < nch; ++ci) {
        const int gc = gc0 + ci, stage = ci & 1;
        if (wave >= 4) { if (ci + 1 < nch) SCAN_WRITE(stage ^ 1); if (ci + 2 < nch) SCAN_ISSUE(gc + 2); }
        else {
            const unsigned char* st = shm + stage * STG; const unsigned sa = ldsb + (unsigned)(stage * STG);
            const unsigned q_ = ((unsigned)lane & 15u) >> 2, pp_ = (unsigned)lane & 3u, blk_ = ((unsigned)lane >> 4) & 1u, h_ = (unsigned)lane >> 5;
            const unsigned lb_ = 2u * blk_ + (pp_ >> 1);
            const unsigned An0 = 256u * (8u * h_ + q_) + 16u * (lb_ ^ (2u * h_)) + 8u * (pp_ & 1u), An1 = 256u * (8u * h_ + 4u + q_) + 16u * (lb_ ^ (2u * h_ + 1u)) + 8u * (pp_ & 1u);
            const unsigned Ap0 = 256u * (4u * h_ + q_) + 16u * (lb_ ^ h_) + 8u * (pp_ & 1u), Ap1 = 256u * (8u + 4u * h_ + q_) + 16u * (lb_ ^ (2u + h_)) + 8u * (pp_ & 1u);
            const unsigned Cq0 = 64u * (0u ^ q_), Cq1 = 64u * (1u ^ q_), Cq2 = 64u * (2u ^ q_), Cq3 = 64u * (3u ^ q_), Cc = 64u * ((unsigned)c ^ q_);
            f32x16 o;
#pragma unroll
            for (int g = 0; g < 4; ++g) {
                const u32x2 w = *(const u32x2*)(st + 24576 + (((c * 4 + g) * 2 + hh) * 32 + r) * 8);
                o[4 * g] = __uint_as_float(w.x << 16); o[4 * g + 1] = __uint_as_float(w.x & 0xffff0000u); o[4 * g + 2] = __uint_as_float(w.y << 16); o[4 * g + 3] = __uint_as_float(w.y & 0xffff0000u);
            }
            f32x16 ws = zero16();
#pragma unroll
            for (int hf = 0; hf < (KIND ? 2 : 4); ++hf) {
                constexpr int GK = KIND ? 4 : 2;
                bf16x8 aq[GK], aw[GK];
#pragma unroll
                for (int k = 0; k < GK; ++k) {
                    aq[k] = *(const bf16x8*)(st + offb(r, 2 * (GK * hf + k) + hh));
                    if (!KIND) aw[k] = *(const bf16x8*)(st + 32768 + offb(r, 2 * (GK * hf + k) + hh));
                }
                __builtin_amdgcn_sched_barrier(0);
#pragma unroll
                for (int k = 0; k < GK; ++k) {
                    const int ss = GK * hf + k;
                    const bf16x8 b = pack_step(S[ss >> 1], ss & 1);
                    o = MFMA32(aq[k], b, o);
                    if (!KIND) ws = MFMA32(aw[k], b, ws);
                }
                __builtin_amdgcn_sched_barrier(0);
            }
            {
                bf16_t* od = odst + (size_t)gc * 32 * 512 + h * 128 + 32 * c + r;
#pragma unroll
                for (int reg = 0; reg < 16; ++reg) od[(size_t)crow(reg, hh) * 512] = cvt1(o[reg]);
            }
            if (KIND) {
#pragma unroll
                for (int i = 0; i < 4; ++i)
#pragma unroll
                    for (int g = 0; g < 4; ++g) {
                        const f32x4 d = *(const f32x4*)(st + 40960 + (32 * i + 8 * g + 4 * hh) * 4);
                        S[i][4 * g] *= d[0]; S[i][4 * g + 1] *= d[1]; S[i][4 * g + 2] *= d[2]; S[i][4 * g + 3] *= d[3];
                    }
#pragma unroll
                for (int ks = 0; ks < 2; ++ks) {
                    const unsigned k0_ = sa + 8192u + 4096u * ks + An0, k1_ = sa + 8192u + 4096u * ks + An1;
                    const Frag4 fa = tr_quad(k0_ + Cq0, k1_ + Cq0, k0_ + Cq1, k1_ + Cq1, k0_ + Cq2, k1_ + Cq2, k0_ + Cq3, k1_ + Cq3);
                    const bf16x8 b = tr_pair(sa + 16384u + 4096u * ks + An0 + Cc, sa + 16384u + 4096u * ks + An1 + Cc);
#pragma unroll
                    for (int i = 0; i < 4; ++i) S[i] = MFMA32(fa.f[i], b, S[i]);
                }
            } else {
                f32x16 uu;
#pragma unroll
                for (int g = 0; g < 4; ++g) {
                    const u32x2 w = *(const u32x2*)(st + 16384 + (((c * 4 + g) * 2 + hh) * 32 + r) * 8);
                    uu[4 * g] = __uint_as_float(w.x << 16) - ws[4 * g]; uu[4 * g + 1] = __uint_as_float(w.x & 0xffff0000u) - ws[4 * g + 1];
                    uu[4 * g + 2] = __uint_as_float(w.y << 16) - ws[4 * g + 2]; uu[4 * g + 3] = __uint_as_float(w.y & 0xffff0000u) - ws[4 * g + 3];
                }
                const float aL = *(const float*)(st + 40960);
#pragma unroll
                for (int i = 0; i < 4; ++i) S[i] *= aL;
#pragma unroll
                for (int ks = 0; ks < 2; ++ks) {
                    const unsigned k0_ = sa + 8192u + 4096u * ks + Ap0, k1_ = sa + 8192u + 4096u * ks + Ap1;
                    const Frag4 fa = tr_quad(k0_ + Cq0, k1_ + Cq0, k0_ + Cq1, k1_ + Cq1, k0_ + Cq2, k1_ + Cq2, k0_ + Cq3, k1_ + Cq3);
                    const bf16x8 b = pack_step(uu, ks);
#pragma unroll
                    for (int i = 0; i < 4; ++i) S[i] = MFMA32(fa.f[i], b, S[i]);
                }
            }
        }
        LBAR();
    }
#undef SCAN_ISSUE
#undef SCAN_WRITE
    if (wave < 4) {
        float* so = p.out + (KIND ? (grp ? O_HGS : O_HGP) : (grp ? O_GDS : O_GDP)) + (size_t)((l * (grp ? 32 : 16) + bseq) * 4 + h) * 16384 + 32 * c + r;
#pragma unroll
        for (int i = 0; i < 4; ++i)
#pragma unroll
            for (int reg = 0; reg < 16; ++reg) so[(32 * i + crow(reg, hh)) * 128] = S[i][reg];
    }
    __syncthreads();
}

__device__ __forceinline__ void phase_scan(const Params& p, int l, unsigned char* shm) {
    const unsigned ldsb = (unsigned)(size_t)shm;
    const bool two_ = gridDim.x == 256;
    const int b_ = (int)blockIdx.x, G_ = (int)gridDim.x;
    const int nit = two_ ? (b_ < 128 ? 1 : 2) : (b_ < 384 ? (383 - b_) / G_ + 1 : 0);
    for (int it = 0; it < nit; ++it) {
        const int u = two_ ? (b_ < 128 ? b_ : b_ + 128 * it) : b_ + it * G_;
        int kind, grp, idx;
        if (u < 64) { kind = 0; grp = 0; idx = u; } else if (u < 128) { kind = 1; grp = 0; idx = u - 64; } else if (u < 256) { kind = 0; grp = 1; idx = u - 128; } else { kind = 1; grp = 1; idx = u - 256; }
        const int h = idx & 3, bseq = idx >> 2;
        if (kind == 0) scan_chain<0>(p, l, grp, bseq, h, shm, ldsb); else scan_chain<1>(p, l, grp, bseq, h, shm, ldsb);
    }
    if (l == 0 && gridDim.x == 256 && blockIdx.x >= 128) convert_tiles(p, (float*)shm, 1536, 8320, (int)blockIdx.x - 128, 128);
}

#define XB_TMO      128
#define XB_XCNT(j)  (256  + 64 * (j))
#define XB_XSUB(j)  (1280 + 64 * (j))
#define XB_XGEN(j)  (2304 + 64 * (j))
#define XB_TOP      3328
#define XB_TOPGEN   3392
#define XCD_BAR_WORDS 3456
#define XB_SPIN_CAP (1u << 18)

__device__ __forceinline__ unsigned xb_ld(unsigned* p)              { return __hip_atomic_load(p, __ATOMIC_RELAXED, __HIP_MEMORY_SCOPE_AGENT); }
__device__ __forceinline__ unsigned xb_add(unsigned* p, unsigned v) { return __hip_atomic_fetch_add(p, v, __ATOMIC_RELAXED, __HIP_MEMORY_SCOPE_AGENT); }
__device__ __forceinline__ unsigned xb_xcc_id() { return (unsigned)__builtin_amdgcn_s_getreg((3 << 11) | 20) & 0xFu; }
#define XB_SPIN(cond, bar) do { unsigned _sp = 0; while (cond) { __builtin_amdgcn_s_sleep(1); \
    if ((++_sp & 255u) == 0u) { if (xb_ld(&(bar)[XB_TMO])) break; if (_sp > XB_SPIN_CAP) { atomicAdd(&(bar)[XB_TMO], 1u); break; } } } } while (0)

struct XcdBarrier {
    unsigned* bar; unsigned x;
    volatile LAS unsigned* st;
};

__device__ __forceinline__ XcdBarrier xcd_barrier_post(unsigned* bar, volatile LAS unsigned* st) {
    XcdBarrier b; b.bar = bar; b.x = xb_xcc_id(); b.st = st;
    if (threadIdx.x == 0) (void)xb_add(&bar[XB_XCNT(b.x)], 1u);
    return b;
}
__device__ __forceinline__ void xcd_barrier_complete(unsigned* bar, unsigned x, unsigned& nloc, unsigned& nx) {
    const unsigned G = gridDim.x * gridDim.y * gridDim.z;
    unsigned sum, cnt, mine, sp = 0u;
    for (;;) {
        sum = 0u; cnt = 0u; mine = 0u;
#pragma unroll
        for (unsigned j = 0; j < 16; ++j) { const unsigned c = xb_ld(&bar[XB_XCNT(j)]); sum += c; cnt += (c > 0u) ? 1u : 0u; mine = (j == x) ? c : mine; }
        if (sum == G) break;
        __builtin_amdgcn_s_sleep(1);
        if ((++sp & 255u) == 0u) { if (xb_ld(&bar[XB_TMO])) break; if (sp > XB_SPIN_CAP) { atomicAdd(&bar[XB_TMO], 1u); break; } }
    }
    nloc = mine > 0u ? mine : 1u; nx = cnt > 0u ? cnt : 1u;
}

__device__ __forceinline__ void xcd_barrier(const XcdBarrier& b) {
    asm volatile("s_waitcnt vmcnt(0)" ::: "memory");
    __syncthreads();
    if (threadIdx.x == 0) {
        unsigned* bar = b.bar;
        __builtin_amdgcn_s_waitcnt(0);
        unsigned nloc = b.st[0], nx = b.st[1];
        if (nloc == 0u) { xcd_barrier_complete(bar, b.x, nloc, nx); b.st[0] = nloc; b.st[1] = nx; }
        const unsigned old = xb_add(&bar[XB_XSUB(b.x)], 1u);
        const unsigned gen = old / nloc;
        if (old + 1u == (gen + 1u) * nloc) {
            __builtin_amdgcn_fence(__ATOMIC_RELEASE, "agent");
            asm volatile("s_waitcnt vmcnt(0)" ::: "memory");
            const unsigned og = xb_add(&bar[XB_TOP], 1u);
            const unsigned tg = og / nx;
            if (og + 1u == (tg + 1u) * nx) xb_add(&bar[XB_TOPGEN], 1u);
            else XB_SPIN(xb_ld(&bar[XB_TOPGEN]) == tg, bar);
            __builtin_amdgcn_fence(__ATOMIC_ACQUIRE, "agent");
            xb_add(&bar[XB_XGEN(b.x)], 1u);
            asm volatile("s_waitcnt vmcnt(0)" ::: "memory");
        } else {
            XB_SPIN(xb_ld(&bar[XB_XGEN(b.x)]) == gen, bar);
            __builtin_amdgcn_fence(__ATOMIC_ACQUIRE, "agent");
            asm volatile("s_waitcnt vmcnt(0)" ::: "memory");
        }
    }
    __syncthreads();
}


template <int S_> __device__ __forceinline__ void layer_phase(const Params& p, const int l, unsigned char* shm) {
    float* L = (float*)shm; LAS unsigned char* lds = (LAS unsigned char*)shm;
    const bf16_t* wt = (const bf16_t*)(p.ws + WS_WT) + (size_t)l * WT_LAYER;
    bf16_t* seg = (bf16_t*)(p.ws + WS_SEG); bf16_t* H = (bf16_t*)(p.ws + WS_H); bf16_t* E = (bf16_t*)(p.ws + WS_E0);
    const float* MODl = (const float*)(p.ws + WS_MOD) + (size_t)l * 48 * 6144;
    float* X = p.out;
    pg8::StaticOrder S;
    if constexpr (S_ == 0) phase_norm<0>(p, l, L);
    if constexpr (S_ == 1) { const pg8::Gemm g{H, wt + WT_IN, MROWS, 4096, 1024, 1024}; S.init(MROWS, 4096, (int)gridDim.x, (int)blockIdx.x);
              const EpiB<4> E_{seg, 512, 512, SEGSZ, nullptr, (bf16_t*)(p.ws + WS_HALO)}; pg8::gemm_phase(lds, g, S, E_); }
    if constexpr (S_ == 2) phase_conv(p, l, L);
    if constexpr (S_ == 3) phase_prep(p, l, shm);
    if constexpr (S_ == 4) phase_scan(p, l, shm);
    if constexpr (S_ == 5) { phase_post(p, l); __syncthreads();
              const pg8::Gemm g{H, wt + WT_IN + (size_t)4096 * 1024, MROWS, 2048, 1024, 1024}; S.init(MROWS, 2048, (int)gridDim.x, (int)blockIdx.x);
              const EpiB<1> E_{seg, 1024, 1024, 4 * SEGSZ, nullptr, nullptr}; pg8::gemm_phase(lds, g, S, E_); }
    if constexpr (S_ == 6) { S.init(MROWS, 1024, (int)gridDim.x, (int)blockIdx.x);
              { const pg8::Gemm g{seg + 2 * SEGSZ, wt + WT_PA, MROWS, 1024, 512, 512}; const EpiB<2> E_{H, 1024, 0, 0, seg, nullptr}; pg8::gemm_phase(lds, g, S, E_); }
              { const pg8::Gemm g{E + 2 * SEGSZ, wt + WT_PB, MROWS, 1024, 512, 512}; const EpiB<3> E_{H, 1024, 0, 0, seg + 4 * SEGSZ, nullptr}; pg8::gemm_phase(lds, g, S, E_); } }
    if constexpr (S_ == 7) { { const pg8::Gemm g{H, wt + WT_OUT, NPROW, 1024, 1024, 1024}; S.init(NPROW, 1024, (int)gridDim.x, (int)blockIdx.x);
                const EpiResU E_{l == 0 ? p.in[0] : X, X, MODl + 2048}; pg8::gemm_phase(lds, g, S, E_); }
              { int ks_ = 512; asm volatile("" : "+s"(ks_)); const pg8::Gemm g{H, wt + WT_OUT, MROWS, 1024, ks_, 1024}; const SliceOrder SO{128, 4, 2, 512, 32, (int)gridDim.x, (int)blockIdx.x};
                const EpiRes2 E_{l == 0 ? p.in[1] : X + (size_t)NPROW * 1024, X, (float*)(p.ws + WS_E0) + (size_t)1024 * 1024, MODl + 2048}; pg8::gemm_phase(lds, g, SO, E_); } }
    if constexpr (S_ == 8) phase_norm<1>(p, l, L);
    if constexpr (S_ == 9) { const pg8::Gemm g{H, wt + WT_UP, MROWS, 5632, 1024, 1024}; S.init(MROWS, 5632, (int)gridDim.x, (int)blockIdx.x);
              const EpiUp E_{seg}; pg8::gemm_phase(lds, g, S, E_); }
    if constexpr (S_ == 10) { { const pg8::Gemm g{seg, wt + WT_DOWN, NPROW, 1024, 2816, 2816}; S.init(NPROW, 1024, (int)gridDim.x, (int)blockIdx.x);
                const EpiResU E_{X, X, MODl + 5120}; pg8::gemm_phase(lds, g, S, E_); }
              { int ks_ = 1408; asm volatile("" : "+s"(ks_)); const pg8::Gemm g{seg, wt + WT_DOWN, MROWS, 1024, ks_, 2816}; const SliceOrder SO{128, 4, 2, 1408, 32, (int)gridDim.x, (int)blockIdx.x};
                const EpiRes2 E_{X + (size_t)NPROW * 1024, X, (float*)(p.ws + WS_E0), MODl + 5120}; pg8::gemm_phase(lds, g, SO, E_); } }
}

#define IN_(k) (lo <= (k) && (k) < hi)
#define SEAM_(k) do { if (IN_(k) && IN_((k) + 1)) { if ((k) == 0) grid.sync(); else xcd_barrier(xbar); } } while (0)
#define LPH_(l, s) do { if (IN_(1 + 11 * (l) + (s))) layer_phase<s>(p, l, shm); SEAM_(1 + 11 * (l) + (s)); } while (0)
#define LAYER_(l) do { LPH_(l, 0); LPH_(l, 1); LPH_(l, 3); LPH_(l, 4); LPH_(l, 5); LPH_(l, 6); LPH_(l, 7); LPH_(l, 8); LPH_(l, 9); LPH_(l, 10); } while (0)

__global__ void __launch_bounds__(512, 2) mega(Params p) {
    extern __shared__ __attribute__((aligned(16))) unsigned char shm[];
    cg::grid_group grid = cg::this_grid();
    const int lo = p.ph0, hi = p.ph1;
    __shared__ uint4 xb_words;
    if (threadIdx.x == 0) xb_words = make_uint4(0u, 0u, 0u, 0u);
    __syncthreads();
    const XcdBarrier xbar = xcd_barrier_post((unsigned*)(p.ws + WS_BAR), (volatile LAS unsigned*)&xb_words);
    if (IN_(0)) phase_prologue(p, (float*)shm);
    SEAM_(0);
    LAYER_(0);
    LAYER_(1);
    if (IN_(23)) phase_norm<2>(p, 0, (float*)shm);
}

extern "C" void kernel_launch(void* const* d_in, const int* in_sizes, int n_in, void* d_out, int out_size, void* d_ws, size_t ws_size, hipStream_t stream) {
    constexpr int kLds = 131072;
    static int grid = 0;
    if (grid == 0) {
        if (n_in != 24 || ws_size < WS_END) { fprintf(stderr, "kernel_launch: unexpected n_in %d / ws %zu (need %zu)\n", n_in, ws_size, (size_t)WS_END); grid = -1; return; }
        int dev = 0, cus = 0, per_cu = 0;
        if (hipGetDevice(&dev) != hipSuccess || hipDeviceGetAttribute(&cus, hipDeviceAttributeMultiprocessorCount, dev) != hipSuccess) { grid = -1; return; }
        if (hipFuncSetAttribute((const void*)mega, hipFuncAttributeMaxDynamicSharedMemorySize, kLds) != hipSuccess) { fprintf(stderr, "kernel_launch: hipFuncSetAttribute failed\n"); grid = -1; return; }
        if (hipOccupancyMaxActiveBlocksPerMultiprocessor(&per_cu, (const void*)mega, 512, kLds) != hipSuccess || per_cu < 1) { fprintf(stderr, "kernel_launch: occupancy query says %d\n", per_cu); grid = -1; return; }
        grid = cus * per_cu;
    }
    if (grid < 0) return;
    if (hipMemsetAsync((unsigned char*)d_ws + WS_BAR, 0, 16384, stream) != hipSuccess) { fprintf(stderr, "kernel_launch: memset failed\n"); return; }
    Params p{};
    for (int i = 0; i < 24; ++i) p.in[i] = (const float*)d_in[i];
    p.out = (float*)d_out; p.ws = (unsigned char*)d_ws;
#if defined(MULTI_LAUNCH)
    for (int ph = 0; ph < 24; ++ph) { p.ph0 = ph; p.ph1 = ph + 1; hipLaunchKernelGGL(mega, dim3(grid), dim3(512), kLds, stream, p); }
#else
    p.ph0 = 0; p.ph1 = 24;
    void* args[] = {&p};
    const hipError_t e = hipLaunchCooperativeKernel((const void*)mega, dim3(grid), dim3(512), args, kLds, stream);
    if (e != hipSuccess) fprintf(stderr, "kernel_launch: cooperative launch failed: %s (grid %d)\n", hipGetErrorString(e), grid);
#endif
}
```

```cpp
#include <hip/hip_runtime.h>
#include <hip/hip_cooperative_groups.h>
#include <cstdio>
namespace cg = cooperative_groups;

namespace pg8 {
#define PG8_LAS __attribute__((address_space(3)))
typedef unsigned short bf16_t;
typedef short bf16x8 __attribute__((ext_vector_type(8)));
typedef float f32x4 __attribute__((ext_vector_type(4)));
typedef unsigned u32x4 __attribute__((ext_vector_type(4)));
constexpr int BM = 256, BK = 64, HALF = 128, HTB = HALF * BK * 2  , STAGE_BYTES = 8 * HTB, NXCD = 8, WGM = 8;

__host__ __device__ __forceinline__ int lds_byte(int r, int c) { const int st = (r >> 4) * 2 + (c >> 5), rr = r & 15, cc = c & 31, ob = rr * 64 + cc * 2; return st * 1024 + (ob ^ (((ob >> 9) & 1) << 5)); }
__host__ __device__ __forceinline__ void stage_rc(int b, int& R, int& C) { const int st = b / 1024, sb = b % 1024, swz = sb ^ (((sb >> 9) & 1) << 5); R = (st >> 1) * 16 + swz / 64; C = (st & 1) * 32 + (swz % 64) / 2; }
__host__ __device__ __forceinline__ int perm32(int rho) { const int n = rho >> 4, i = rho & 15; return 8 * (i >> 2) + 4 * n + (i & 3); }

struct Unit { int pm, pn, ko; };
struct Gemm { const bf16_t* A; const bf16_t* Bt; int M, N, K, ld; };

struct StaticOrder {
    int nM, nN, nwg, G, c;
    __host__ __device__ void init(int M, int N, int G_, int c_) { nM = M / BM; nN = N / BM; nwg = nM * nN; G = G_; c = c_; }
    __host__ __device__ bool next(int i, Unit& u) const {
        const long L = (long)i * G + c; if (L >= nwg) return false;
        int wgid = (int)L; { const int q = nwg / NXCD, r = nwg % NXCD, xcd = wgid % NXCD, off = wgid / NXCD; wgid = (xcd < r ? xcd * (q + 1) : r * (q + 1) + (xcd - r) * q) + off; }
        const int nig = WGM * nN, gid = wgid / nig, fm = gid * WGM, gsz = (nM - fm) < WGM ? (nM - fm) : WGM;
        u.pm = fm + ((wgid % nig) % gsz); u.pn = (wgid % nig) / gsz; u.ko = 0; return true;
    }
    __device__ __forceinline__ void a_ready(const Unit&) const {}
    __device__ __forceinline__ void done(const Unit&) const {}
};
__device__ __forceinline__ unsigned cvt_pk_bf16(float lo, float hi) { unsigned r; asm volatile("v_cvt_pk_bf16_f32 %0, %1, %2" : "=v"(r) : "v"(lo), "v"(hi)); return r; }
template <class Epi, class Sched>
__device__ __forceinline__ void gemm_phase(PG8_LAS unsigned char* lds, const Gemm g, const Sched& S, const Epi& E) {
    const int tid = threadIdx.x, wid = __builtin_amdgcn_readfirstlane(tid >> 6), lane = tid & 63, wr = wid >> 2, wc = wid & 3, fr = lane & 15, fq = lane >> 4;
    const int K = g.ld, nt = g.K / BK;
    unsigned voffA[2], voffB[2];
#pragma unroll
    for (int i = 0; i < 2; ++i) { int R, C; stage_rc(tid * 16 + i * 8192, R, C); const int Rb = Epi::PERM ? ((R & ~31) + perm32(R & 31)) : R;
        voffA[i] = (unsigned)(R * K + C) * 2u; voffB[i] = (unsigned)(Rb * K + C) * 2u; }
    const size_t kstep = (size_t)(BK * 2);
    const size_t hstep = (size_t)HALF * K * 2;
    const size_t tstep = 2 * hstep;
    const unsigned ldsw = (unsigned)wid * 1024u;
    const int aoff = lds_byte(wr * 64 + fr, fq * 8), boff = lds_byte(wc * 32 + fr, fq * 8);
#define PG8_SA(b, h) (((b) * 2 + (h)) * HTB)
#define PG8_SB(b, h) ((4 + (b) * 2 + (h)) * HTB)
#define PG8_STAGE(bufoff, gbase, voff) do { _Pragma("unroll") for (int _i = 0; _i < 2; ++_i) \
        __builtin_amdgcn_global_load_lds((const unsigned*)((const char*)(gbase) + (voff)[_i]), (PG8_LAS unsigned*)(lds + (bufoff) + ldsw + _i * 8192), 16, 0, 0); } while (0)
#define PG8_LDA(dst, b, h) do { _Pragma("unroll") for (int m = 0; m < 4; ++m) _Pragma("unroll") for (int k = 0; k < 2; ++k) dst[m][k] = *(const PG8_LAS bf16x8*)(lds + PG8_SA(b, h) + aoff + m * 2048 + k * 1024); } while (0)
#define PG8_LDB(dst, b, h) do { _Pragma("unroll") for (int n = 0; n < 2; ++n) _Pragma("unroll") for (int k = 0; k < 2; ++k) dst[n][k] = *(const PG8_LAS bf16x8*)(lds + PG8_SB(b, h) + boff + n * 2048 + k * 1024); } while (0)
#define PG8_MMA(ai, bj, At, Bt) do { __builtin_amdgcn_s_setprio(1); _Pragma("unroll") for (int m = 0; m < 4; ++m) _Pragma("unroll") for (int n = 0; n < 2; ++n) _Pragma("unroll") for (int k = 0; k < 2; ++k) \
        acc[ai][bj][m][n] = __builtin_amdgcn_mfma_f32_16x16x32_bf16(Bt[n][k], At[m][k], acc[ai][bj][m][n], 0, 0, 0); __builtin_amdgcn_s_setprio(0); } while (0)
#define PG8_WAIT_V(n) asm volatile("s_waitcnt vmcnt(" #n ")" ::: "memory")
#define PG8_WAIT_L(n) asm volatile("s_waitcnt lgkmcnt(" #n ")" ::: "memory")
#define PG8_BAR __builtin_amdgcn_s_barrier()
#define PG8_SCHED __builtin_amdgcn_sched_barrier(0)
    Unit cur, nxt; int ui = 0;
    if (!S.next(0, cur)) return;
    f32x4 acc[2][2][4][2];
#pragma unroll
    for (int a = 0; a < 2; ++a)
#pragma unroll
        for (int b = 0; b < 2; ++b)
#pragma unroll
            for (int m = 0; m < 4; ++m)
#pragma unroll
                for (int n = 0; n < 2; ++n) acc[a][b][m][n] = (f32x4){0.f, 0.f, 0.f, 0.f};
    bf16x8 At[4][2], B0[2][2], B1[2][2];
    const char* cA = (const char*)g.A + (size_t)cur.pm * tstep + (size_t)cur.ko * 2; const char* cB = (const char*)g.Bt + (size_t)cur.pn * tstep + (size_t)cur.ko * 2;
    S.a_ready(cur);
    PG8_STAGE(PG8_SB(0, 0), cB, voffB); PG8_STAGE(PG8_SA(0, 0), cA, voffA); PG8_STAGE(PG8_SB(0, 1), cB + hstep, voffB); PG8_STAGE(PG8_SA(0, 1), cA + hstep, voffA);
    if (wr == 1) PG8_BAR;
    PG8_WAIT_V(4); PG8_BAR;
    PG8_STAGE(PG8_SB(1, 0), cB + kstep, voffB); PG8_STAGE(PG8_SA(1, 0), cA + kstep, voffA); PG8_STAGE(PG8_SB(1, 1), cB + hstep + kstep, voffB);
    PG8_WAIT_V(6); PG8_BAR;
    for (;;) {
        const bool has_next = S.next(ui + 1, nxt);
        const char* nA = has_next ? (const char*)g.A + (size_t)nxt.pm * tstep + (size_t)nxt.ko * 2 : cA; const char* nB = has_next ? (const char*)g.Bt + (size_t)nxt.pn * tstep + (size_t)nxt.ko * 2 : cB;
        for (int t = 0; t < nt; t += 2) {
            const bool last = (t == nt - 2);
            const char* a1 = cA + (size_t)(t + 1) * kstep;
            const char* a2 = last ? nA : cA + (size_t)(t + 2) * kstep; const char* b2 = last ? nB : cB + (size_t)(t + 2) * kstep;
            const char* a3 = a2 + kstep; const char* b3 = b2 + kstep;
            if (last && has_next) S.a_ready(nxt);
            PG8_LDB(B0, 0, 0); PG8_SCHED; PG8_LDA(At, 0, 0); PG8_STAGE(PG8_SA(1, 1), a1 + hstep, voffA);
            PG8_WAIT_L(8); PG8_BAR; PG8_WAIT_L(0); PG8_MMA(0, 0, At, B0); PG8_BAR; PG8_SCHED;
            PG8_LDB(B1, 0, 1); PG8_STAGE(PG8_SB(0, 0), b2, voffB);
            PG8_BAR; PG8_WAIT_L(0); PG8_MMA(0, 1, At, B1); PG8_BAR;
            PG8_LDA(At, 0, 1); PG8_STAGE(PG8_SA(0, 0), a2, voffA);
            PG8_BAR; PG8_WAIT_L(0); PG8_MMA(1, 0, At, B0); PG8_BAR; PG8_SCHED;
            PG8_STAGE(PG8_SB(0, 1), b2 + hstep, voffB);
            PG8_WAIT_V(6); PG8_BAR; PG8_MMA(1, 1, At, B1); PG8_BAR;
            PG8_LDB(B0, 1, 0); PG8_SCHED; PG8_LDA(At, 1, 0); PG8_STAGE(PG8_SA(0, 1), a2 + hstep, voffA);
            PG8_WAIT_L(8); PG8_BAR; PG8_WAIT_L(0); PG8_MMA(0, 0, At, B0); PG8_BAR; PG8_SCHED;
            PG8_LDB(B1, 1, 1); PG8_STAGE(PG8_SB(1, 0), b3, voffB);
            PG8_BAR; PG8_WAIT_L(0); PG8_MMA(0, 1, At, B1); PG8_BAR;
            PG8_LDA(At, 1, 1); PG8_STAGE(PG8_SA(1, 0), a3, voffA);
            PG8_BAR; PG8_WAIT_L(0); PG8_MMA(1, 0, At, B0); PG8_BAR; PG8_SCHED;
            PG8_STAGE(PG8_SB(1, 1), b3 + hstep, voffB);
            PG8_WAIT_V(6); PG8_BAR; PG8_MMA(1, 1, At, B1); PG8_BAR;
        }
        if constexpr (!Epi::AFTER_DRAIN) { E(acc, cur, wr, wc, fr, fq); S.done(cur); }
        if (!has_next) break;
#pragma unroll
        for (int a = 0; a < 2; ++a)
#pragma unroll
            for (int b = 0; b < 2; ++b)
#pragma unroll
                for (int m = 0; m < 4; ++m)
#pragma unroll
                    for (int n = 0; n < 2; ++n) acc[a][b][m][n] = (f32x4){0.f, 0.f, 0.f, 0.f};
        cur = nxt; cA = nA; cB = nB; ++ui;
    }
    PG8_WAIT_V(0);
    if (wr == 0) PG8_BAR;
    PG8_BAR;
    if constexpr (Epi::AFTER_DRAIN) { E.fused(acc, cur, wr, wc, fr, fq, lds, wid, lane); S.done(cur); }
#undef PG8_SA
#undef PG8_SB
#undef PG8_STAGE
#undef PG8_LDA
#undef PG8_LDB
#undef PG8_MMA
#undef PG8_WAIT_V
#undef PG8_WAIT_L
#undef PG8_BAR
#undef PG8_SCHED
}
}

using pg8::bf16_t; using pg8::bf16x8; using pg8::f32x4; using pg8::u32x4; using pg8::Unit;
#define LAS __attribute__((address_space(3)))

constexpr int NPROW = 32768, MROWS = 33792;
constexpr size_t SEGSZ = (size_t)MROWS * 512;
constexpr size_t WT_IN = 0, WT_PA = WT_IN + (size_t)6144 * 1024, WT_PB = WT_PA + (size_t)1024 * 512, WT_OUT = WT_PB + (size_t)1024 * 512,
                 WT_UP = WT_OUT + (size_t)1024 * 1024, WT_DOWN = WT_UP + (size_t)5632 * 1024, WT_LAYER = WT_DOWN + (size_t)1024 * 2816;
constexpr size_t WS_WT = 0;
constexpr size_t WS_SEG = WS_WT + 2 * WT_LAYER * 2;
constexpr size_t WS_H = WS_SEG + 8 * SEGSZ * 2;
constexpr size_t WS_MOD = WS_H + (size_t)MROWS * 1024 * 2;
constexpr size_t WS_GAB = WS_MOD + (size_t)2 * 48 * 6144 * 4;
constexpr size_t WS_LB = WS_GAB + (size_t)MROWS * 8 * 4;
constexpr size_t WS_E0 = WS_LB + 1024 * 4;
constexpr size_t WS_DG = WS_E0 + 3 * SEGSZ * 2;
constexpr size_t WS_AL = WS_DG + (size_t)4224 * 128 * 4;
constexpr size_t WS_BAR = WS_AL + 4224 * 4 + 128;
constexpr size_t WS_HALO = WS_BAR + 16384;
constexpr size_t WS_END = WS_HALO + (size_t)1056 * 3 * 1536 * 2;
constexpr size_t O_HGP = 34603008, O_GDP = O_HGP + 2097152, O_CVP = O_GDP + 2097152, O_HGS = O_CVP + 147456, O_GDS = O_HGS + 4194304, O_CVS = O_GDS + 4194304;

struct Params { const float* in[24]; float* out; unsigned char* ws; int ph0, ph1; };

__device__ __forceinline__ void unpack8(const u32x4 w, float* f) {
    f[0] = __uint_as_float(w.x << 16); f[1] = __uint_as_float(w.x & 0xffff0000u); f[2] = __uint_as_float(w.y << 16); f[3] = __uint_as_float(w.y & 0xffff0000u);
    f[4] = __uint_as_float(w.z << 16); f[5] = __uint_as_float(w.z & 0xffff0000u); f[6] = __uint_as_float(w.w << 16); f[7] = __uint_as_float(w.w & 0xffff0000u);
}
__device__ __forceinline__ u32x4 pack8(const float* f) {
    u32x4 w; w.x = pg8::cvt_pk_bf16(f[0], f[1]); w.y = pg8::cvt_pk_bf16(f[2], f[3]); w.z = pg8::cvt_pk_bf16(f[4], f[5]); w.w = pg8::cvt_pk_bf16(f[6], f[7]); return w;
}
__device__ __forceinline__ float sigm(float x) { return __builtin_amdgcn_rcpf(1.0f + __expf(-x)); }
__device__ __forceinline__ float silu_(float x) { return x * __builtin_amdgcn_rcpf(1.0f + __expf(-x)); }
__device__ __forceinline__ float silu_fast(float x) { return x * __builtin_amdgcn_rcpf(1.0f + __expf(-x)); }
__device__ __forceinline__ int seq_of(int r) { return r < NPROW ? (r >> 11) : 16 + ((r - NPROW) >> 5); }

template <int MODE> struct EpiB {
    static constexpr bool PERM = true, AFTER_DRAIN = false;
    bf16_t* O; int ldc; int split_cols; size_t split_stride; const bf16_t* G; bf16_t* HALO;
    __device__ __forceinline__ void operator()(const f32x4 (&acc)[2][2][4][2], const Unit& u, int wr, int wc, int fr, int fq) const {
        asm volatile("" : "+v"(fr), "+v"(fq));
        const int row0 = u.pm * 256 + wr * 64 + fr; int colt = u.pn * 256; bf16_t* base = O;
        if (split_cols) { const int t = colt / split_cols; base += (size_t)t * split_stride; colt -= t * split_cols; }
        const int col0 = colt + wc * 32 + 8 * fq, gcol0 = u.pn * 256 + wc * 32 + 8 * fq;
#pragma unroll
        for (int aim = 0; aim < 4; ++aim) {
            const int ai = aim >> 1;
            u32x4 gq[4][2], oq[4][2];
            if (MODE == 2 || MODE == 3) {
#pragma unroll
                for (int mm = 0; mm < 2; ++mm)
#pragma unroll
                    for (int bj = 0; bj < 2; ++bj) {
                        const int m = (aim & 1) * 2 + mm, r = row0 + ai * 128 + m * 16;
                        gq[m][bj] = *(const u32x4*)(G + (size_t)r * 1024 + gcol0 + bj * 128);
                        if (MODE == 3) oq[m][bj] = *(const u32x4*)(base + (size_t)r * ldc + col0 + bj * 128);
                    }
            }
#pragma unroll
            for (int m = (aim & 1) * 2; m < (aim & 1) * 2 + 2; ++m) {
                const int r = row0 + ai * 128 + m * 16;
                bf16_t* rowp = base + (size_t)r * ldc + col0;
#pragma unroll
                for (int bj = 0; bj < 2; ++bj) {
                    float v[8];
#pragma unroll
                    for (int j = 0; j < 4; ++j) { v[j] = acc[ai][bj][m][0][j]; v[4 + j] = acc[ai][bj][m][1][j]; }
                    if (MODE == 1) {
#pragma unroll
                        for (int j = 0; j < 8; ++j) v[j] = sigm(v[j]);
                        asm volatile("s_nop 1" : "+v"(v[0]), "+v"(v[1]), "+v"(v[2]), "+v"(v[3]), "+v"(v[4]), "+v"(v[5]), "+v"(v[6]), "+v"(v[7]));
                    }
                    if (MODE == 2 || MODE == 3) {
                        float g[8]; unpack8(gq[m][bj], g);
#pragma unroll
                        for (int j = 0; j < 8; ++j) v[j] *= g[j];
                    }
                    if (MODE == 3) {
                        float o[8]; unpack8(oq[m][bj], o);
#pragma unroll
                        for (int j = 0; j < 8; ++j) v[j] += o[j];
                    }
                    const u32x4 pk = pack8(v);
                    *(u32x4*)(rowp + bj * 128) = pk;
                    if (MODE == 4) {
                        const int sg = (u.pn * 256) / 512;
                        if (sg >= 4 && sg <= 6 && (m & 1) && fr >= 13)
                            *(u32x4*)(HALO + ((size_t)(r >> 5) * 3 + ((r & 31) - 29)) * 1536 + (sg - 4) * 512 + col0 + bj * 128) = pk;
                    }
                }
            }
        }
    }
};
struct EpiUp {
    static constexpr bool PERM = true, AFTER_DRAIN = false;
    bf16_t* O;
    __device__ __forceinline__ void operator()(const f32x4 (&acc)[2][2][4][2], const Unit& u, int wr, int wc, int fr, int fq) const {
        asm volatile("" : "+v"(fr), "+v"(fq));
        const int row0 = u.pm * 256 + wr * 64 + fr, col0 = u.pn * 128 + wc * 32 + 8 * fq;
#pragma unroll
        for (int ai = 0; ai < 2; ++ai)
#pragma unroll
            for (int m = 0; m < 4; ++m) {
                const int r = row0 + ai * 128 + m * 16;
                float v[8];
#pragma unroll
                for (int j = 0; j < 4; ++j) { v[j] = silu_fast(acc[ai][0][m][0][j]) * acc[ai][1][m][0][j]; v[4 + j] = silu_fast(acc[ai][0][m][1][j]) * acc[ai][1][m][1][j]; }
                *(u32x4*)(O + (size_t)r * 2816 + col0) = pack8(v);
            }
    }
};
struct EpiRes {
    static constexpr bool PERM = false, AFTER_DRAIN = false;
    const float* xp; const float* xs; float* X; const float* modg;
    __device__ __forceinline__ void operator()(const f32x4 (&acc)[2][2][4][2], const Unit& u, int wr, int wc, int fr, int fq) const {
        asm volatile("" : "+v"(fr), "+v"(fq));
        const int row0 = u.pm * 256 + wr * 64 + fr, col0 = u.pn * 256 + wc * 32 + 4 * fq;
#pragma unroll
        for (int ai = 0; ai < 2; ++ai)
#pragma unroll
            for (int m = 0; m < 4; ++m) {
                const int r = row0 + ai * 128 + m * 16;
                const float* gp = modg + (size_t)seq_of(r) * 6144 + col0;
                const float* xr = (r < NPROW ? xp + (size_t)r * 1024 : xs + (size_t)(r - NPROW) * 1024) + col0;
                float* xo = X + (size_t)r * 1024 + col0;
#pragma unroll
                for (int bj = 0; bj < 2; ++bj)
#pragma unroll
                    for (int n = 0; n < 2; ++n) {
                        const int c = bj * 128 + n * 16;
                        const f32x4 g4 = *(const f32x4*)(gp + c), x4 = *(const f32x4*)(xr + c);
                        *(f32x4*)(xo + c) = x4 + g4 * acc[ai][bj][m][n];
                    }
            }
    }
};

struct SliceOrder {
    int pm0, nN, nks, Ks, n, G, c;
    __device__ __forceinline__ bool next(int i, Unit& u) const {
        const int L = i * G + c; if (L >= n) return false;
        const int tile = L / nks, ks = L - tile * nks;
        u.pm = pm0 + tile / nN; u.pn = tile % nN; u.ko = ks * Ks; return true;
    }
    __device__ __forceinline__ void a_ready(const Unit&) const {}
    __device__ __forceinline__ void done(const Unit&) const {}
};
struct EpiRes2 {
    static constexpr bool PERM = false, AFTER_DRAIN = false, PAIR = false;
    const float* xs; float* X; float* T; const float* modg;
    __device__ __forceinline__ void operator()(const f32x4 (&acc)[2][2][4][2], const Unit& u, int wr, int wc, int fr, int fq) const {
        asm volatile("" : "+v"(fr), "+v"(fq));
        const int row0 = u.pm * 256 + wr * 64 + fr, col0 = u.pn * 256 + wc * 32 + 4 * fq;
        const bool first = (u.ko == 0);
#pragma unroll
        for (int aim = 0; aim < 4; ++aim) {
            const int ai = aim >> 1, m0 = (aim & 1) * 2;
            f32x4 g4[2][2], x4[2][2][2];
            {
                const float* gp = modg + (size_t)seq_of(row0 + ai * 128 + m0 * 16) * 6144 + col0;
#pragma unroll
                for (int bj = 0; bj < 2; ++bj)
#pragma unroll
                    for (int n = 0; n < 2; ++n) g4[bj][n] = *(const f32x4*)(gp + bj * 128 + n * 16);
            }
            if (first) {
#pragma unroll
                for (int mm = 0; mm < 2; ++mm) {
                    const float* xr = xs + (size_t)(row0 + ai * 128 + (m0 + mm) * 16 - NPROW) * 1024 + col0;
#pragma unroll
                    for (int bj = 0; bj < 2; ++bj)
#pragma unroll
                        for (int n = 0; n < 2; ++n) x4[mm][bj][n] = *(const f32x4*)(xr + bj * 128 + n * 16);
                }
            }
#pragma unroll
            for (int mm = 0; mm < 2; ++mm) {
                const int r = row0 + ai * 128 + (m0 + mm) * 16;
                float* xo = X + (size_t)r * 1024 + col0; float* to = T + (size_t)(r - NPROW) * 1024 + col0;
#pragma unroll
                for (int bj = 0; bj < 2; ++bj)
#pragma unroll
                    for (int n = 0; n < 2; ++n) {
                        const int c = bj * 128 + n * 16;
                        if (first) *(f32x4*)(xo + c) = x4[mm][bj][n] + g4[bj][n] * acc[ai][bj][m0 + mm][n];
                        else *(f32x4*)(to + c) = g4[bj][n] * acc[ai][bj][m0 + mm][n];
                    }
            }
        }
    }
};

struct EpiResU {
    static constexpr bool PERM = false, AFTER_DRAIN = false;
    const float* xin; float* X; const float* modg;
    __device__ __forceinline__ void operator()(const f32x4 (&acc)[2][2][4][2], const Unit& u, int wr, int wc, int fr, int fq) const {
        asm volatile("" : "+v"(fr), "+v"(fq));
        const int row0 = u.pm * 256 + wr * 64 + fr, col0 = u.pn * 256 + wc * 32 + 4 * fq;
        const float* gp = modg + (size_t)((u.pm * 256) >> 11) * 6144 + col0;
        f32x4 g4[2][2];
#pragma unroll
        for (int bj = 0; bj < 2; ++bj)
#pragma unroll
            for (int n = 0; n < 2; ++n) g4[bj][n] = *(const f32x4*)(gp + bj * 128 + n * 16);
#pragma unroll
        for (int aim = 0; aim < 4; ++aim) {
            const int ai = aim >> 1, m0 = (aim & 1) * 2;
            f32x4 x[2][2][2];
#pragma unroll
            for (int mm = 0; mm < 2; ++mm) {
                const float* xr = xin + (size_t)(row0 + ai * 128 + (m0 + mm) * 16) * 1024 + col0;
#pragma unroll
                for (int bj = 0; bj < 2; ++bj)
#pragma unroll
                    for (int n = 0; n < 2; ++n) x[mm][bj][n] = *(const f32x4*)(xr + bj * 128 + n * 16);
            }
#pragma unroll
            for (int mm = 0; mm < 2; ++mm) {
                float* xo = X + (size_t)(row0 + ai * 128 + (m0 + mm) * 16) * 1024 + col0;
#pragma unroll
                for (int bj = 0; bj < 2; ++bj)
#pragma unroll
                    for (int n = 0; n < 2; ++n) *(f32x4*)(xo + bj * 128 + n * 16) = x[mm][bj][n] + g4[bj][n] * acc[ai][bj][m0 + mm][n];
            }
        }
    }
};

struct WTile { const float* src; bf16_t* dst; int ld, K, k0, n0, col0; };
__device__ __forceinline__ WTile wtile_of(const Params& p, int t) {
    WTile w; const int l = t / 4160; int r = t % 4160; int ntn, mp = 0;
    bf16_t* dst = (bf16_t*)(p.ws + WS_WT) + (size_t)l * WT_LAYER;
    if (r < 1536) { w.src = p.in[10] + (size_t)l * 1024 * 6152; w.ld = 6152; w.K = 1024; ntn = 96; dst += WT_IN; mp = 1; }
    else if (r < 1664) { r -= 1536; w.src = p.in[17] + (size_t)l * 512 * 1024; w.ld = 1024; w.K = 512; ntn = 16; dst += WT_PA; }
    else if (r < 1792) { r -= 1664; w.src = p.in[18] + (size_t)l * 512 * 1024; w.ld = 1024; w.K = 512; ntn = 16; dst += WT_PB; }
    else if (r < 2048) { r -= 1792; w.src = p.in[19] + (size_t)l * 1024 * 1024; w.ld = 1024; w.K = 1024; ntn = 16; dst += WT_OUT; }
    else if (r < 3456) { r -= 2048; w.src = p.in[21] + (size_t)l * 1024 * 5632; w.ld = 5632; w.K = 1024; ntn = 88; dst += WT_UP; mp = 2; }
    else { r -= 3456; w.src = p.in[22] + (size_t)l * 2816 * 1024; w.ld = 1024; w.K = 2816; ntn = 16; dst += WT_DOWN; }
    w.dst = dst; w.k0 = (r / ntn) * 64; w.n0 = (r % ntn) * 64; w.col0 = w.n0;
    if (mp == 1) w.col0 = w.n0 < 3584 ? w.n0 : w.n0 + 8;
    if (mp == 2) { const int tt = w.n0 >> 8, i = w.n0 & 255; w.col0 = i < 128 ? 128 * tt + i : 2816 + 128 * tt + (i - 128); }
    return w;
}
__device__ __forceinline__ void convert_tiles(const Params& p, float* L, int t_lo, int t_hi, int rank, int nranks) {
    const int tid = threadIdx.x;
    f32x4 nv[2]; int t = t_lo + rank;
    const int r0 = tid >> 4, c4 = tid & 15;
    if (t < t_hi) { const WTile w = wtile_of(p, t); nv[0] = *(const f32x4*)(w.src + (size_t)(w.k0 + r0) * w.ld + w.col0 + c4 * 4); nv[1] = *(const f32x4*)(w.src + (size_t)(w.k0 + r0 + 32) * w.ld + w.col0 + c4 * 4); }
    while (t < t_hi) {
        const WTile w = wtile_of(p, t);
        const f32x4 v0 = nv[0], v1 = nv[1];
        const int tn = t + nranks;
        if (tn < t_hi) { const WTile wn = wtile_of(p, tn); nv[0] = *(const f32x4*)(wn.src + (size_t)(wn.k0 + r0) * wn.ld + wn.col0 + c4 * 4); nv[1] = *(const f32x4*)(wn.src + (size_t)(wn.k0 + r0 + 32) * wn.ld + wn.col0 + c4 * 4); }
        { float* tt = L + r0 * 65 + c4 * 4; tt[0] = v0[0]; tt[1] = v0[1]; tt[2] = v0[2]; tt[3] = v0[3]; tt += 32 * 65; tt[0] = v1[0]; tt[1] = v1[1]; tt[2] = v1[2]; tt[3] = v1[3]; }
        __syncthreads();
        {
            const int n = tid >> 3, k8 = tid & 7; float f[8];
#pragma unroll
            for (int e = 0; e < 8; ++e) f[e] = L[(k8 * 8 + e) * 65 + n];
            *(u32x4*)(w.dst + (size_t)(w.n0 + n) * w.K + w.k0 + k8 * 8) = pack8(f);
        }
        __syncthreads();
        t = tn;
    }
}

__device__ __forceinline__ void phase_prologue(const Params& p, float* L) {
    const int tid = threadIdx.x, wave = tid >> 6, lane = tid & 63;
    float* MOD = (float*)(p.ws + WS_MOD);
    if (blockIdx.x == 0) {
        float* LB = (float*)(p.ws + WS_LB);
        const float a = p.in[11][tid], b = p.in[11][512 + tid], m = fmaxf(a, b), ea = __expf(a - m), eb = __expf(b - m);
        LB[tid] = 0.0f; LB[512 + tid] = eb / (ea + eb);
    }
    for (int u = blockIdx.x; u < 192; u += gridDim.x) {
        const int l = u / 96, col = (u % 96) * 64 + lane;
        bf16_t* sC = (bf16_t*)L;
        __syncthreads();
        for (int i = tid; i < 48 * 512; i += 512) {
            const int row = i >> 9, k2 = (i & 511) * 2;
            const float* cp = row < 16 ? p.in[5] + row * 1024 + k2 : p.in[6] + (row - 16) * 1024 + k2;
            ((unsigned*)sC)[i] = pg8::cvt_pk_bf16(silu_(cp[0]), silu_(cp[1]));
        }
        __syncthreads();
        float acc[48];
#pragma unroll
        for (int j = 0; j < 48; ++j) acc[j] = 0.f;
        const float* wp = p.in[7] + ((size_t)l * 1024 + wave * 128) * 6144 + col;
        float wn[8];
#pragma unroll
        for (int e = 0; e < 8; ++e) wn[e] = wp[(size_t)e * 6144];
#pragma unroll 1
        for (int k = 0; k < 128; k += 8) {
            float w[8];
#pragma unroll
            for (int e = 0; e < 8; ++e) w[e] = wn[e];
            if (k + 8 < 128) {
#pragma unroll
                for (int e = 0; e < 8; ++e) wn[e] = wp[(size_t)(k + 8 + e) * 6144];
            }
#pragma unroll
            for (int j = 0; j < 48; ++j) {
                float c8[8]; unpack8(*(const u32x4*)(sC + j * 1024 + wave * 128 + k), c8);
#pragma unroll
                for (int e = 0; e < 8; ++e) acc[j] = fmaf(c8[e], w[e], acc[j]);
            }
        }
        __syncthreads();
#pragma unroll
        for (int j = 0; j < 48; ++j) L[(wave * 48 + j) * 64 + lane] = acc[j];
        __syncthreads();
        for (int i = tid; i < 48 * 64; i += 512) {
            float a = 0.f;
#pragma unroll
            for (int w8 = 0; w8 < 8; ++w8) a += L[w8 * 3072 + i];
            const int row = i >> 6, cc = (u % 96) * 64 + (i & 63);
            MOD[((size_t)l * 48 + row) * 6144 + cc] = a + p.in[8][l * 6144 + cc];
        }
    }
    __syncthreads();
    if (gridDim.x == 256) { if (blockIdx.x >= 192) convert_tiles(p, L, 0, 1536, (int)blockIdx.x - 192, 64); }
    else convert_tiles(p, L, 0, 8320, (int)blockIdx.x, (int)gridDim.x);
}

template <int MODE, int NR> __device__ __forceinline__ void norm_task(const Params& p, int l, const float* L, int row0, const f32x4 (&nw4)[4], int lane) {
    float* X = p.out; bf16_t* H = (bf16_t*)(p.ws + WS_H);
    const float* MOD = (const float*)(p.ws + WS_MOD) + (size_t)l * 48 * 6144;
    float* GAB = (float*)(p.ws + WS_GAB);
    const float* xr = (MODE == 0 && l == 0) ? (row0 < NPROW ? p.in[0] + (size_t)row0 * 1024 : p.in[1] + (size_t)(row0 - NPROW) * 1024) : X + (size_t)row0 * 1024;
    f32x4 v[NR][4];
#pragma unroll
    for (int rr = 0; rr < NR; ++rr)
#pragma unroll
        for (int i = 0; i < 4; ++i) v[rr][i] = *(const f32x4*)(xr + rr * 1024 + i * 256 + lane * 4);
    if (row0 >= NPROW && !(MODE == 0 && l == 0)) {
        const float* T = (const float*)(p.ws + WS_E0) + (MODE == 1 ? (size_t)1024 * 1024 : 0) + (size_t)(row0 - NPROW) * 1024;
#pragma unroll
        for (int rr = 0; rr < NR; ++rr)
#pragma unroll
            for (int i = 0; i < 4; ++i) {
                v[rr][i] += *(const f32x4*)(T + rr * 1024 + i * 256 + lane * 4);
                if (MODE != 2) *(f32x4*)(X + (size_t)(row0 + rr) * 1024 + i * 256 + lane * 4) = v[rr][i];
            }
    }
    f32x4 s4[4], b4[4];
    if (MODE != 2) {
        const float* sh = MOD + (size_t)seq_of(row0) * 6144 + (MODE == 0 ? 0 : 3072); const float* sc = sh + 1024;
#pragma unroll
        for (int i = 0; i < 4; ++i) { s4[i] = *(const f32x4*)(sc + i * 256 + lane * 4) + 1.0f; b4[i] = *(const f32x4*)(sh + i * 256 + lane * 4); }
    }
#pragma unroll
    for (int rr = 0; rr < NR; ++rr) {
        float ss = 0.f;
#pragma unroll
        for (int i = 0; i < 4; ++i) ss += v[rr][i][0] * v[rr][i][0] + v[rr][i][1] * v[rr][i][1] + v[rr][i][2] * v[rr][i][2] + v[rr][i][3] * v[rr][i][3];
#pragma unroll
        for (int o = 32; o >= 1; o >>= 1) ss += __shfl_xor(ss, o);
        const float rstd = rsqrtf(ss * (1.0f / 1024.0f) + 1e-6f);
        const int row = row0 + rr;
        if (MODE == 2) {
#pragma unroll
            for (int i = 0; i < 4; ++i) *(f32x4*)(X + (size_t)row * 1024 + i * 256 + lane * 4) = v[rr][i] * rstd * nw4[i];
        } else {
#pragma unroll
            for (int i = 0; i < 4; ++i) {
                v[rr][i] = (v[rr][i] * rstd * nw4[i]) * s4[i] + b4[i];
                typedef unsigned u32x2_ __attribute__((ext_vector_type(2)));
                u32x2_ w; w.x = pg8::cvt_pk_bf16(v[rr][i][0], v[rr][i][1]); w.y = pg8::cvt_pk_bf16(v[rr][i][2], v[rr][i][3]);
                *(u32x2_*)(H + (size_t)row * 1024 + i * 256 + lane * 4) = w;
            }
        }
    }
    if (MODE == 0) {
        float d[NR][8];
#pragma unroll
        for (int j = 0; j < 8; ++j) {
            f32x4 w4[4];
#pragma unroll
            for (int i = 0; i < 4; ++i) w4[i] = *(const f32x4*)(L + j * 1024 + i * 256 + lane * 4);
#pragma unroll
            for (int rr = 0; rr < NR; ++rr) {
                float a = 0.f;
#pragma unroll
                for (int i = 0; i < 4; ++i) a += v[rr][i][0] * w4[i][0] + v[rr][i][1] * w4[i][1] + v[rr][i][2] * w4[i][2] + v[rr][i][3] * w4[i][3];
#pragma unroll
                for (int o = 32; o >= 1; o >>= 1) a += __shfl_xor(a, o);
                d[rr][j] = a;
            }
        }
        if (lane < NR) {
            float dd[8];
#pragma unroll
            for (int j = 0; j < 8; ++j) {
                float t = d[0][j];
#pragma unroll
                for (int rr = 1; rr < NR; ++rr) t = lane == rr ? d[rr][j] : t;
                dd[j] = t;
            }
            *(f32x4*)(GAB + (size_t)(row0 + lane) * 8) = (f32x4){dd[0], dd[1], dd[2], dd[3]}; *(f32x4*)(GAB + (size_t)(row0 + lane) * 8 + 4) = (f32x4){dd[4], dd[5], dd[6], dd[7]};
        }
    }
}
template <int MODE> __device__ __forceinline__ void phase_norm(const Params& p, int l, float* L) {
    const int tid = threadIdx.x, wave = tid >> 6, lane = tid & 63;
    const float* nw = MODE == 0 ? p.in[9] + l * 1024 : (MODE == 1 ? p.in[20] + l * 1024 : p.in[23]);
    if (MODE == 0) {
        const float* win = p.in[10] + (size_t)l * 1024 * 6152 + 3584;
        for (int i = tid; i < 8192; i += 512) { const int k = i >> 3, j = i & 7; L[j * 1024 + k] = win[(size_t)k * 6152 + j]; }
        __syncthreads();
    }
    f32x4 nw4[4];
#pragma unroll
    for (int i = 0; i < 4; ++i) nw4[i] = *(const f32x4*)(nw + i * 256 + lane * 4);
    const int gw = blockIdx.x * 8 + wave, nwv = gridDim.x * 8;
    for (int task = gw; task < NPROW / 4; task += nwv) norm_task<MODE, 4>(p, l, L, task * 4, nw4, lane);
    for (int t = gw; t < MROWS - NPROW; t += nwv) norm_task<MODE, 1>(p, l, L, NPROW + t, nw4, lane);
    __syncthreads();
}

__device__ __forceinline__ void phase_post(const Params& p, int l) {
    const int tid = threadIdx.x, wave = tid >> 6, lane = tid & 63;
    bf16_t* seg = (bf16_t*)(p.ws + WS_SEG);
    const bool wgt = gridDim.x == 256;
    const int b_ = (int)blockIdx.x;
    const int it0 = wgt ? (b_ >= 32 ? b_ - 32 : 2016 + b_) : b_, its = wgt ? (b_ >= 32 ? 224 : 32) : (int)gridDim.x, itn = wgt ? (b_ >= 32 ? 2016 : 2112) : 2112;
    for (int it = it0; it < itn; it += its) {
        const int task = it * 8 + wave;
        const int br = task & 1, row0 = (task >> 1) * 4;
        bf16_t* O = (br ? (bf16_t*)(p.ws + WS_E0) + 2 * SEGSZ : seg + 2 * SEGSZ) + (size_t)row0 * 512 + lane * 8;
        const bf16_t* Gt = seg + (br ? 7 : 3) * SEGSZ + (size_t)row0 * 512 + lane * 8;
        const float* nw = (br ? p.in[16] : p.in[12]) + l * 128 + (lane & 15) * 8;
        u32x4 ow[4], gw[4];
#pragma unroll
        for (int rr = 0; rr < 4; ++rr) { ow[rr] = *(const u32x4*)(O + rr * 512); gw[rr] = *(const u32x4*)(Gt + rr * 512); }
        float nwv[8];
#pragma unroll
        for (int j = 0; j < 8; ++j) nwv[j] = nw[j];
#pragma unroll
        for (int rr = 0; rr < 4; ++rr) {
            float o[8], g[8]; unpack8(ow[rr], o); unpack8(gw[rr], g);
            float ss = 0.f;
#pragma unroll
            for (int j = 0; j < 8; ++j) ss += o[j] * o[j];
            ss += __shfl_xor(ss, 1); ss += __shfl_xor(ss, 2); ss += __shfl_xor(ss, 4); ss += __shfl_xor(ss, 8);
            const float rstd = rsqrtf(ss * (1.0f / 128.0f) + 1e-6f);
#pragma unroll
            for (int j = 0; j < 8; ++j) o[j] = (o[j] * rstd * nwv[j]) * silu_(g[j]);
            *(u32x4*)(O + rr * 512) = pack8(o);
        }
    }
}

typedef float f32x16 __attribute__((ext_vector_type(16)));
typedef float f32x2_t __attribute__((ext_vector_type(2)));
typedef __bf16 bf16x2_t __attribute__((ext_vector_type(2)));
typedef unsigned u32x2 __attribute__((ext_vector_type(2)));
typedef short s16x4 __attribute__((ext_vector_type(4)));
#define MFMA32(a, b, c) __builtin_amdgcn_mfma_f32_32x32x16_bf16((a), (b), (c), 0, 0, 0)
__device__ __forceinline__ unsigned cvt2(float lo, float hi) { const f32x2_t v = {lo, hi}; return __builtin_bit_cast(unsigned, __builtin_convertvector(v, bf16x2_t)); }
__device__ __forceinline__ u32x4 pack8c(const float* f) { u32x4 w; w.x = cvt2(f[0], f[1]); w.y = cvt2(f[2], f[3]); w.z = cvt2(f[4], f[5]); w.w = cvt2(f[6], f[7]); return w; }
__device__ __forceinline__ bf16_t cvt1(float x) { return (bf16_t)(cvt2(x, 0.0f) & 0xffffu); }
__device__ __forceinline__ unsigned xrow(unsigned row) { return ((row & 3u) << 2) | ((row >> 2) & 3u); }
__device__ __forceinline__ unsigned offb(unsigned row, unsigned ch) { return 256u * row + 16u * (ch ^ xrow(row)); }
__device__ __forceinline__ unsigned swap23(unsigned c) { return (c & ~12u) | ((c & 4u) << 1) | ((c & 8u) >> 1); }
__device__ __forceinline__ int crow(int reg, int h) { return (reg & 3) + 8 * (reg >> 2) + 4 * h; }
__device__ __forceinline__ unsigned tr_addr(unsigned lane, unsigned c, unsigned ks, unsigned t) {
    const unsigned h = lane >> 5, blk = (lane >> 4) & 1, q = (lane & 15) >> 2, pp = lane & 3;
    return offb(16 * ks + 8 * h + 4 * t + q, 4 * c + 2 * blk + (pp >> 1)) + 8 * (pp & 1);
}
__device__ __forceinline__ unsigned tr_addr_perm(unsigned lane, unsigned c, unsigned ks, unsigned t) {
    const unsigned h = lane >> 5, blk = (lane >> 4) & 1, q = (lane & 15) >> 2, pp = lane & 3;
    return offb(16 * ks + 8 * t + 4 * h + q, 4 * c + 2 * blk + (pp >> 1)) + 8 * (pp & 1);
}
__device__ __forceinline__ bf16x8 tr_pair(unsigned a0, unsigned a1) {
    s16x4 lo, hi;
    asm volatile("ds_read_b64_tr_b16 %0, %2\n\tds_read_b64_tr_b16 %1, %3\n\ts_waitcnt lgkmcnt(0)" : "=&v"(lo), "=&v"(hi) : "v"(a0), "v"(a1) : "memory");
    return __builtin_shufflevector(lo, hi, 0, 1, 2, 3, 4, 5, 6, 7);
}
struct Frag4 { bf16x8 f[4]; };
__device__ __forceinline__ Frag4 tr_quad(unsigned a0, unsigned a1, unsigned a2, unsigned a3, unsigned a4, unsigned a5, unsigned a6, unsigned a7) {
    s16x4 v0, v1, v2, v3, v4, v5, v6, v7;
    asm volatile("ds_read_b64_tr_b16 %0, %8\n\tds_read_b64_tr_b16 %1, %9\n\tds_read_b64_tr_b16 %2, %10\n\tds_read_b64_tr_b16 %3, %11\n\t"
                 "ds_read_b64_tr_b16 %4, %12\n\tds_read_b64_tr_b16 %5, %13\n\tds_read_b64_tr_b16 %6, %14\n\tds_read_b64_tr_b16 %7, %15\n\ts_waitcnt lgkmcnt(0)"
                 : "=&v"(v0), "=&v"(v1), "=&v"(v2), "=&v"(v3), "=&v"(v4), "=&v"(v5), "=&v"(v6), "=&v"(v7)
                 : "v"(a0), "v"(a1), "v"(a2), "v"(a3), "v"(a4), "v"(a5), "v"(a6), "v"(a7) : "memory");
    Frag4 r;
    r.f[0] = __builtin_shufflevector(v0, v1, 0, 1, 2, 3, 4, 5, 6, 7); r.f[1] = __builtin_shufflevector(v2, v3, 0, 1, 2, 3, 4, 5, 6, 7);
    r.f[2] = __builtin_shufflevector(v4, v5, 0, 1, 2, 3, 4, 5, 6, 7); r.f[3] = __builtin_shufflevector(v6, v7, 0, 1, 2, 3, 4, 5, 6, 7);
    return r;
}
__device__ __forceinline__ bf16x8 pack_step(const f32x16& x, const int s) {
    u32x4 w; w.x = cvt2(x[8 * s], x[8 * s + 1]); w.y = cvt2(x[8 * s + 2], x[8 * s + 3]); w.z = cvt2(x[8 * s + 4], x[8 * s + 5]); w.w = cvt2(x[8 * s + 6], x[8 * s + 7]);
    return __builtin_bit_cast(bf16x8, w);
}
__device__ __forceinline__ f32x16 zero16() { f32x16 z; for (int i = 0; i < 16; ++i) z[i] = 0.f; return z; }

__device__ __forceinline__ void phase_conv(const Params& p, int l, float* L) {
    const int tid = threadIdx.x, wave = tid >> 6, lane = tid & 63;
    for (int i = tid; i < 6144; i += 512) L[i] = p.in[13][(size_t)l * 6144 + i];
    __syncthreads();
    const bf16_t* seg = (const bf16_t*)(p.ws + WS_SEG); bf16_t* E = (bf16_t*)(p.ws + WS_E0);
    for (int task = blockIdx.x * 8 + wave; task < 3 * (MROWS / 8); task += gridDim.x * 8) {
        const int rb = task / 3, part = task - rb * 3, row0 = rb * 8;
        const int grp = row0 >= NPROW, t0 = grp ? ((row0 - NPROW) & 31) : (row0 & 2047), T = grp ? 32 : 2048, seqi = grp ? ((row0 - NPROW) >> 5) : (row0 >> 11);
        const bf16_t* src = seg + (size_t)(4 + part) * SEGSZ + (size_t)row0 * 512 + lane * 8;
        const int ch = part * 512 + lane * 8;
        float x[11][8];
#pragma unroll
        for (int i = 0; i < 8; ++i) unpack8(*(const u32x4*)(src + (size_t)i * 512), x[3 + i]);
        if (t0 > 0) {
#pragma unroll
            for (int j = 1; j <= 3; ++j) unpack8(*(const u32x4*)(src - (size_t)j * 512), x[3 - j]);
        } else if (grp) {
#pragma unroll
            for (int j = 0; j < 3; ++j) {
                const float* sc = p.in[4] + (size_t)((l * 32 + seqi) * 3 + j) * 1536 + ch;
                const f32x4 a = *(const f32x4*)sc, b = *(const f32x4*)(sc + 4);
                x[j][0] = a[0]; x[j][1] = a[1]; x[j][2] = a[2]; x[j][3] = a[3]; x[j][4] = b[0]; x[j][5] = b[1]; x[j][6] = b[2]; x[j][7] = b[3];
            }
        } else {
#pragma unroll
            for (int j = 0; j < 3; ++j)
#pragma unroll
                for (int e = 0; e < 8; ++e) x[j][e] = 0.f;
        }
        float cw[4][8];
#pragma unroll
        for (int j = 0; j < 4; ++j)
#pragma unroll
            for (int e = 0; e < 8; ++e) cw[j][e] = L[j * 1536 + ch + e];
#pragma unroll
        for (int i = 0; i < 8; ++i) {
            float y[8]; float ss = 0.f;
#pragma unroll
            for (int e = 0; e < 8; ++e) {
                float a = x[i][e] * cw[0][e] + x[i + 1][e] * cw[1][e] + x[i + 2][e] * cw[2][e] + x[i + 3][e] * cw[3][e];
                a = silu_(a); y[e] = a; ss += a * a;
            }
            if (part < 2) {
                ss += __shfl_xor(ss, 1); ss += __shfl_xor(ss, 2); ss += __shfl_xor(ss, 4); ss += __shfl_xor(ss, 8);
                const float sc = rsqrtf(ss + 1e-6f) * (part == 0 ? 0.08838834764831845f : 1.0f);
#pragma unroll
                for (int e = 0; e < 8; ++e) y[e] *= sc;
            }
            *(u32x4*)(E + (size_t)part * SEGSZ + (size_t)(row0 + i) * 512 + lane * 8) = pack8(y);
            const int t = t0 + i;
            if (t >= T - 3) {
                float* co = p.out + (grp ? O_CVS + (size_t)((l * 32 + seqi) * 3 + (t - (T - 3))) * 1536 : O_CVP + (size_t)((l * 16 + seqi) * 3 + (t - (T - 3))) * 1536) + ch;
                *(f32x4*)co = (f32x4){x[3 + i][0], x[3 + i][1], x[3 + i][2], x[3 + i][3]}; *(f32x4*)(co + 4) = (f32x4){x[3 + i][4], x[3 + i][5], x[3 + i][6], x[3 + i][7]};
            }
        }
    }
    __syncthreads();
}

__device__ __forceinline__ unsigned char* slice_ptr(bf16_t* segbase, int gc, int h) { return (unsigned char*)(segbase + (size_t)gc * 32 * 512 + h * 128); }
__device__ __forceinline__ void store_cfrag_global(unsigned char* sl, const f32x16& v, int c, int r, int hh) {
#pragma unroll
    for (int g = 0; g < 4; ++g) {
        const unsigned off = (unsigned)((((c * 4 + g) * 2 + hh) * 32 + r) * 8);
        u32x2 w; w.x = cvt2(v[4 * g], v[4 * g + 1]); w.y = cvt2(v[4 * g + 2], v[4 * g + 3]);
        *(u32x2*)(sl + (size_t)(off >> 8) * 1024 + (off & 255u)) = w;
    }
}

__device__ __forceinline__ void pair_prep(const Params& p, int l, int gc, int h, unsigned char* shm, unsigned ldsb, const u32x4 rq, const u32x4 rk, const u32x4 rv, const u32x4 hrq, const u32x4 hrf, const u32x4 hrv, const u32x4 halo, const float gab_a, const float gab_b, const float (&lbv)[8]) {
    int tid = threadIdx.x; asm volatile("" : "+v"(tid));
    const int wave = __builtin_amdgcn_readfirstlane(tid >> 6), lane = tid & 63, r = lane & 31, hh = lane >> 5, tok = tid >> 4, c8 = tid & 15;
    unsigned char* QT = shm; unsigned char* KT = shm + 8192; unsigned char* KB = shm + 16384; unsigned char* VB = shm + 24576;
    float* QGF = (float*)(shm + 32768); float* MM = (float*)(shm + 49152); bf16_t* QKM = (bf16_t*)(shm + 53248); bf16_t* TM = (bf16_t*)(shm + 55296);
    unsigned char* WI = shm + 57344; unsigned char* UI = shm + 65536; float* LA = (float*)(shm + 73728); float* BETA = LA + 32; float* GS = LA + 64;
    bf16_t* seg = (bf16_t*)(p.ws + WS_SEG); bf16_t* E = (bf16_t*)(p.ws + WS_E0);
    unsigned char* sQ = slice_ptr(E, gc, h); unsigned char* sK = slice_ptr(E + SEGSZ, gc, h); unsigned char* sV = slice_ptr(E + 2 * SEGSZ, gc, h);
    unsigned char* sW = slice_ptr(seg + 4 * SEGSZ, gc, h); unsigned char* sOI = slice_ptr(seg + 5 * SEGSZ, gc, h);
    bf16_t* RW = (bf16_t*)(shm + 32768); const float* CW = (const float*)(shm + 120832);
    {
        *(u32x4*)(RW + (3 + tok) * 384 + c8 * 8) = rq; *(u32x4*)(RW + (3 + tok) * 384 + 128 + c8 * 8) = rk; *(u32x4*)(RW + (3 + tok) * 384 + 256 + c8 * 8) = rv;
        if (tid < 144) { const int hr = tid / 48, cc = tid - hr * 48; *(u32x4*)(RW + hr * 384 + (cc >> 4) * 128 + (cc & 15) * 8) = halo; }
        if ((gc >= 1024 || (gc & 63) == 63) && tok >= 29) {
            float* co = p.out + (gc >= 1024 ? O_CVS + (size_t)((l * 32 + (gc - 1024)) * 3 + (tok - 29)) * 1536 : O_CVP + (size_t)((l * 16 + (gc >> 6)) * 3 + (tok - 29)) * 1536) + h * 128 + c8 * 8;
            float t8[8];
            unpack8(rq, t8); *(f32x4*)co = (f32x4){t8[0], t8[1], t8[2], t8[3]}; *(f32x4*)(co + 4) = (f32x4){t8[4], t8[5], t8[6], t8[7]};
            unpack8(rk, t8); *(f32x4*)(co + 512) = (f32x4){t8[0], t8[1], t8[2], t8[3]}; *(f32x4*)(co + 516) = (f32x4){t8[4], t8[5], t8[6], t8[7]};
            unpack8(rv, t8); *(f32x4*)(co + 1024) = (f32x4){t8[0], t8[1], t8[2], t8[3]}; *(f32x4*)(co + 1028) = (f32x4){t8[4], t8[5], t8[6], t8[7]};
        }
    }
    float q[8], k[8], v[8];
    if (tid < 32) {
        const float xa = gab_a + p.in[15][l * 4 + h], sp_ = xa > 20.0f ? xa : log1pf(__expf(xa));
        LA[tid] = -__expf(p.in[14][l * 4 + h]) * sp_; BETA[tid] = sigm(gab_b);
    }
    float* hLF = (float*)(shm + 75776); float* hPT = (float*)(shm + 92160);
    unsigned char* hQT = shm + 94208; unsigned char* hKT = shm + 102400; unsigned char* hVT = shm + 110592; bf16_t* hAM = (bf16_t*)(shm + 118784);
    bf16_t* hseg = (bf16_t*)(p.ws + WS_SEG);
    unsigned char* hsHQ = slice_ptr(hseg, gc, h); unsigned char* hsHF = slice_ptr(hseg + SEGSZ, gc, h); unsigned char* hsHI = slice_ptr(hseg + 2 * SEGSZ, gc, h); unsigned char* hsOI = slice_ptr(hseg + 6 * SEGSZ, gc, h);
    float* hDG = (float*)(p.ws + WS_DG) + (size_t)(gc * 4 + h) * 128;
    float hq[8], hf[8];
    unpack8(hrq, hq); unpack8(hrf, hf);
    {
        float lf[8];
#pragma unroll
        for (int j = 0; j < 8; ++j) { const float lb = lbv[j]; hf[j] = lb + (1.0f - lb) * sigm(hf[j]); lf[j] = __logf(hf[j]); }
        *(f32x4*)(hLF + tok * 128 + c8 * 8) = (f32x4){lf[0], lf[1], lf[2], lf[3]}; *(f32x4*)(hLF + tok * 128 + c8 * 8 + 4) = (f32x4){lf[4], lf[5], lf[6], lf[7]};
    }
    __syncthreads();
    {
#pragma unroll
        for (int part = 0; part < 3; ++part) {
            float y[8]; float ss = 0.f;
            float x0[8], x1[8], x2[8], x3[8];
            unpack8(*(const u32x4*)(RW + (tok) * 384 + part * 128 + c8 * 8), x0); unpack8(*(const u32x4*)(RW + (tok + 1) * 384 + part * 128 + c8 * 8), x1);
            unpack8(*(const u32x4*)(RW + (tok + 2) * 384 + part * 128 + c8 * 8), x2); unpack8(*(const u32x4*)(RW + (tok + 3) * 384 + part * 128 + c8 * 8), x3);
            const float* cwp = CW + part * 128 + c8 * 8;
#pragma unroll
            for (int e = 0; e < 8; ++e) {
                float a = x0[e] * cwp[e] + x1[e] * cwp[384 + e] + x2[e] * cwp[768 + e] + x3[e] * cwp[1152 + e];
                a = silu_(a); y[e] = a; ss += a * a;
            }
            if (part < 2) {
                ss += __shfl_xor(ss, 1); ss += __shfl_xor(ss, 2); ss += __shfl_xor(ss, 4); ss += __shfl_xor(ss, 8);
                const float sc = rsqrtf(ss + 1e-6f) * (part == 0 ? 0.08838834764831845f : 1.0f);
#pragma unroll
                for (int e = 0; e < 8; ++e) y[e] *= sc;
            }
#pragma unroll
            for (int e = 0; e < 8; ++e) { if (part == 0) q[e] = y[e]; else if (part == 1) k[e] = y[e]; else v[e] = y[e]; }
        }
    }
    if (wave == 0) {
        float g = LA[r];
#pragma unroll
        for (int d = 1; d < 32; d <<= 1) { const float t = __shfl_up(g, d); if (r >= d) g += t; }
        if (lane < 32) GS[lane] = g;
    }
    {
        const int d = tid & 127, part = tid >> 7; float run = 0.f;
#pragma unroll
        for (int i = 0; i < 8; ++i) { run += hLF[(part * 8 + i) * 128 + d]; hLF[(part * 8 + i) * 128 + d] = run; }
        hPT[part * 128 + d] = run;
    }
    __syncthreads();
    {
        const float g = GS[tok], gL = GS[31], be = BETA[tok], eg = __expf(g), ekd = __expf(gL - g);
        float t8[8];
        *(u32x4*)(QT + offb(tok, c8)) = pack8c(q); *(u32x4*)(KT + offb(tok, c8)) = pack8c(k);
#pragma unroll
        for (int j = 0; j < 8; ++j) t8[j] = be * eg * k[j];
        *(u32x4*)(KB + offb(tok, c8)) = pack8c(t8);
#pragma unroll
        for (int j = 0; j < 8; ++j) t8[j] = be * v[j];
        *(u32x4*)(VB + offb(tok, c8)) = pack8c(t8);
        *(f32x4*)(QGF + tok * 128 + c8 * 8) = (f32x4){q[0] * eg, q[1] * eg, q[2] * eg, q[3] * eg}; *(f32x4*)(QGF + tok * 128 + c8 * 8 + 4) = (f32x4){q[4] * eg, q[5] * eg, q[6] * eg, q[7] * eg};
#pragma unroll
        for (int j = 0; j < 8; ++j) t8[j] = k[j] * ekd;
        *(u32x4*)(sK + (size_t)tok * 1024 + 16u * ((unsigned)c8 ^ xrow(tok))) = pack8c(t8);
        if (tid == 0) ((float*)(p.ws + WS_AL))[gc * 4 + h] = __expf(gL);
    }
    {
        float qg[8], qt[8], kt[8], kd[8];
        const int tp = tok >> 3;
        float P0[8], P1[8], P2[8], GT[8], GR[8], GE[8];
        {
            const int d0 = c8 * 8;
#define LD8_(dst, ptr) do { const f32x4 a_ = *(const f32x4*)(ptr), b_ = *(const f32x4*)((ptr) + 4); dst[0] = a_[0]; dst[1] = a_[1]; dst[2] = a_[2]; dst[3] = a_[3]; dst[4] = b_[0]; dst[5] = b_[1]; dst[6] = b_[2]; dst[7] = b_[3]; } while (0)
            LD8_(P0, hPT + d0); LD8_(P1, hPT + 128 + d0); LD8_(P2, hPT + 256 + d0); LD8_(GT, hLF + tok * 128 + d0); LD8_(GR, hLF + 15 * 128 + d0); LD8_(GE, hLF + 31 * 128 + d0);
#undef LD8_
        }
#pragma unroll
        for (int j = 0; j < 8; ++j) {
            const int d = c8 * 8 + j;
            const float p0 = P0[j], p1 = P1[j], p2 = P2[j];
            const float base = tp == 0 ? 0.f : (tp == 1 ? p0 : (tp == 2 ? p0 + p1 : p0 + p1 + p2));
            const float G = GT[j] + base, Gref = GR[j] + p0, GL = GE[j] + p0 + p1 + p2;
            const float kk = 1.0f - hf[j], qs = hq[j] * 0.08838834764831845f;
            qg[j] = qs * __expf(G); qt[j] = qs * __expf(G - Gref); kt[j] = kk * __expf(Gref - G); kd[j] = kk * __expf(GL - G);
            if (tok == 0) hDG[d] = __expf(GL);
        }
        *(u32x4*)(hQT + offb(tok, c8)) = pack8c(qt); *(u32x4*)(hKT + offb(tok, c8)) = pack8c(kt); *(u32x4*)(hVT + offb(tok, c8)) = hrv;
        const unsigned xr = xrow(tok), chA = (unsigned)(c8 & ~1), chB = chA | 1u, eo = (unsigned)(c8 & 1) * 8u;
        u32x2 lo, hi; lo.x = cvt2(qg[0], qg[1]); lo.y = cvt2(qg[2], qg[3]); hi.x = cvt2(qg[4], qg[5]); hi.y = cvt2(qg[6], qg[7]);
        *(u32x2*)(hsHQ + (size_t)tok * 1024 + 16u * (chA ^ xr) + eo) = lo; *(u32x2*)(hsHQ + (size_t)tok * 1024 + 16u * (chB ^ xr) + eo) = hi;
        *(u32x4*)(hsHF + (size_t)tok * 1024 + 16u * ((unsigned)c8 ^ xr)) = pack8c(kd);
        *(u32x4*)(hsHI + (size_t)tok * 1024 + 16u * ((unsigned)c8 ^ xr)) = hrv;
    }
    __syncthreads();
    if (wave < 2) {
        f32x16 acc = zero16();
        {
            bf16x8 fb[8], fa[8];
#pragma unroll
            for (int s = 0; s < 8; ++s) { fb[s] = *(const bf16x8*)(KT + offb(r, 2 * s + hh)); fa[s] = *(const bf16x8*)((wave == 0 ? KT : QT) + offb(r, 2 * s + hh)); }
            __builtin_amdgcn_sched_barrier(0);
#pragma unroll
            for (int s = 0; s < 8; ++s) acc = MFMA32(fa[s], fb[s], acc);
        }
        const float gs = GS[r];
#pragma unroll
        for (int reg = 0; reg < 16; ++reg) {
            const int t = crow(reg, hh); const float dec = __expf(GS[t] - gs);
            if (wave == 0) MM[t * 32 + r] = r < t ? BETA[t] * dec * acc[reg] : 0.0f;
            else QKM[t * 32 + r] = cvt1(r <= t ? dec * acc[reg] : 0.0f);
        }
    }
    if (wave == 2) {
        f32x16 acc = zero16();
        {
            bf16x8 fa[8], fb[8];
#pragma unroll
            for (int s = 0; s < 8; ++s) { fa[s] = *(const bf16x8*)(hQT + offb(r, 2 * s + hh)); fb[s] = *(const bf16x8*)(hKT + offb(r, 2 * s + hh)); }
            __builtin_amdgcn_sched_barrier(0);
#pragma unroll
            for (int s = 0; s < 8; ++s) acc = MFMA32(fa[s], fb[s], acc);
        }
#pragma unroll
        for (int reg = 0; reg < 16; ++reg) { const int t = crow(reg, hh); hAM[t * 32 + r] = cvt1(r <= t ? acc[reg] : 0.0f); }
    }
    __syncthreads();
    if (wave == 0) {
        float Tc[32];
#pragma unroll
        for (int t = 0; t < 32; ++t) Tc[t] = 0.f;
#pragma unroll
        for (int t = 0; t < 32; ++t) {
            float a0 = (t == r) ? 1.0f : 0.0f, a1 = 0.f, a2 = 0.f, a3 = 0.f;
#pragma unroll
            for (int s4 = 0; s4 < t; s4 += 4) {
                const f32x4 m = *(const f32x4*)(MM + t * 32 + s4);
                a0 -= m[0] * Tc[s4]; a1 -= m[1] * Tc[s4 + 1]; a2 -= m[2] * Tc[s4 + 2]; a3 -= m[3] * Tc[s4 + 3];
            }
            Tc[t] = (a0 + a1) + (a2 + a3);
        }
        if (hh == 0) {
#pragma unroll
            for (int t = 0; t < 32; ++t) TM[t * 32 + r] = cvt1(Tc[t]);
        }
    }
    if (wave >= 4) {
        const int c = wave - 4; f32x16 acc = zero16();
#pragma unroll
        for (int ks = 0; ks < 2; ++ks) {
            const bf16x8 a = *(const bf16x8*)((const unsigned char*)hAM + r * 64 + ks * 32 + hh * 16);
            const bf16x8 b = tr_pair(ldsb + 110592 + tr_addr(lane, c, ks, 0), ldsb + 110592 + tr_addr(lane, c, ks, 1));
            acc = MFMA32(a, b, acc);
        }
        store_cfrag_global(hsOI, acc, c, r, hh);
    }
    __syncthreads();
    {
        const int c = wave & 3; const unsigned img = wave < 4 ? 16384u : 24576u;
        f32x16 acc = zero16();
#pragma unroll
        for (int ks = 0; ks < 2; ++ks) {
            const bf16x8 a = *(const bf16x8*)((const unsigned char*)TM + r * 64 + ks * 32 + hh * 16);
            const bf16x8 b = tr_pair(ldsb + img + tr_addr(lane, c, ks, 0), ldsb + img + tr_addr(lane, c, ks, 1));
            acc = MFMA32(a, b, acc);
        }
        const unsigned col = 32u * c + r;
        if (wave < 4) {
            const unsigned pos = swap23(col);
#pragma unroll
            for (int reg = 0; reg < 16; ++reg) {
                const unsigned t = (unsigned)crow(reg, hh); const bf16_t w = cvt1(acc[reg]);
                *(bf16_t*)(WI + offb(t, col >> 3) + 2u * (col & 7u)) = w;
                *(bf16_t*)(sW + (size_t)t * 1024 + 16u * ((pos >> 3) ^ xrow(t)) + 2u * (pos & 7u)) = w;
            }
        } else {
#pragma unroll
            for (int reg = 0; reg < 16; ++reg) { const unsigned t = (unsigned)crow(reg, hh); *(bf16_t*)(UI + offb(t, col >> 3) + 2u * (col & 7u)) = cvt1(acc[reg]); }
            store_cfrag_global(sV, acc, c, r, hh);
        }
    }
    __syncthreads();
    {
        const int c = wave & 3; const unsigned img = wave < 4 ? 57344u : 65536u;
        f32x16 acc = zero16();
#pragma unroll
        for (int ks = 0; ks < 2; ++ks) {
            const bf16x8 a = *(const bf16x8*)((const unsigned char*)QKM + r * 64 + ks * 32 + hh * 16);
            const bf16x8 b = tr_pair(ldsb + img + tr_addr(lane, c, ks, 0), ldsb + img + tr_addr(lane, c, ks, 1));
            acc = MFMA32(a, b, acc);
        }
        if (wave < 4) {
            const unsigned col = 32u * c + r, pos = swap23(col);
#pragma unroll
            for (int reg = 0; reg < 16; ++reg) {
                const unsigned t = (unsigned)crow(reg, hh);
                *(bf16_t*)(sQ + (size_t)t * 1024 + 16u * ((pos >> 3) ^ xrow(t)) + 2u * (pos & 7u)) = cvt1(QGF[t * 128 + col] - acc[reg]);
            }
        } else store_cfrag_global(sOI, acc, c, r, hh);
    }
    __syncthreads();
}

__device__ __forceinline__ void phase_prep(const Params& p, int l, unsigned char* shm) {
    const unsigned ldsb = (unsigned)(size_t)shm;
    const int tid = threadIdx.x, tok = tid >> 4, c8 = tid & 15;
    bf16_t* seg = (bf16_t*)(p.ws + WS_SEG); bf16_t* E = (bf16_t*)(p.ws + WS_E0);
    u32x4 n0 = {0u, 0u, 0u, 0u}, n1 = n0, n2 = n0, n3 = n0, n4 = n0, n5 = n0, n6 = n0; float na = 0.f, nb = 0.f;
    float lbv[8];
#pragma unroll
    for (int j = 0; j < 8; ++j) lbv[j] = ((const float*)(p.ws + WS_LB))[l * 512 + (blockIdx.x & 3) * 128 + c8 * 8 + j];
    {
        float* CWs = (float*)(shm + 120832); const int hfix = blockIdx.x & 3;
        for (int idx = tid; idx < 1536; idx += 512) { const int j = idx / 384, ch = idx - j * 384; CWs[idx] = p.in[13][(size_t)(l * 4 + j) * 1536 + (ch >> 7) * 512 + hfix * 128 + (ch & 127)]; }
        __syncthreads();
    }
#define PREP_LOAD(u_) do { const int i_ = (u_); \
        const unsigned char* s_ = slice_ptr(seg + 4 * SEGSZ, i_ >> 2, i_ & 3) + (size_t)tok * 1024 + c8 * 16; \
        const unsigned char* t_ = slice_ptr(seg, i_ >> 2, i_ & 3) + (size_t)tok * 1024 + c8 * 16; \
        n0 = *(const u32x4*)s_; n1 = *(const u32x4*)(s_ + SEGSZ * 2); n2 = *(const u32x4*)(s_ + SEGSZ * 4); \
        n3 = *(const u32x4*)t_; n4 = *(const u32x4*)(t_ + SEGSZ * 2); n5 = *(const u32x4*)(t_ + SEGSZ * 4); \
        n6 = (u32x4){0u, 0u, 0u, 0u}; \
        if (tid < 32) { const float* gab_ = (const float*)(p.ws + WS_GAB) + (size_t)((i_ >> 2) * 32 + tid) * 8; na = gab_[i_ & 3]; nb = gab_[4 + (i_ & 3)]; } \
        if (tid < 144) { const int g_ = i_ >> 2, h_ = i_ & 3, hr_ = tid / 48, cc_ = tid - hr_ * 48, pt_ = cc_ >> 4, c8h_ = cc_ & 15; \
            if (g_ >= 1024) { const float* sc_ = p.in[4] + (size_t)((l * 32 + (g_ - 1024)) * 3 + hr_) * 1536 + pt_ * 512 + h_ * 128 + c8h_ * 8; \
                const f32x4 a_ = *(const f32x4*)sc_, b_ = *(const f32x4*)(sc_ + 4); float t8_[8] = {a_[0], a_[1], a_[2], a_[3], b_[0], b_[1], b_[2], b_[3]}; n6 = pack8(t8_); } \
            else if ((g_ & 63) != 0) n6 = *(const u32x4*)((const bf16_t*)(p.ws + WS_HALO) + ((size_t)(g_ - 1) * 3 + hr_) * 1536 + pt_ * 512 + h_ * 128 + c8h_ * 8); } } while (0)
    int u = blockIdx.x;
    if (u < 4224) PREP_LOAD(u);
    for (; u < 4224; u += gridDim.x) {
        const u32x4 c0 = n0, c1 = n1, c2 = n2, c3 = n3, c4 = n4, c5 = n5, c6 = n6; const float ca = na, cb = nb;
        const int un = u + (int)gridDim.x;
        if (un < 4224) PREP_LOAD(un);
        pair_prep(p, l, u >> 2, u & 3, shm, ldsb, c0, c1, c2, c3, c4, c5, c6, ca, cb, lbv);
    }
#undef PREP_LOAD
}

constexpr int STG = 41472;
template <int KIND> __device__ __forceinline__ void scan_chain(const Params& p, int l, int grp, int bseq, int h, unsigned char* shm, unsigned ldsb) {
    const int tid = threadIdx.x, wave = tid >> 6, lane = tid & 63, r = lane & 31, hh = lane >> 5, c = wave & 3;
    const int nch = grp ? 1 : 64, gc0 = grp ? 1024 + bseq : bseq * 64;
    bf16_t* seg = (bf16_t*)(p.ws + WS_SEG); bf16_t* E = (bf16_t*)(p.ws + WS_E0);
    const bf16_t* src0 = KIND ? seg : E; const bf16_t* src1 = KIND ? seg + SEGSZ : E + SEGSZ; const bf16_t* src2 = KIND ? seg + 2 * SEGSZ : E + 2 * SEGSZ;
    const bf16_t* src3 = KIND ? seg + 6 * SEGSZ : seg + 5 * SEGSZ; const bf16_t* src4 = seg + 4 * SEGSZ;
    bf16_t* odst = KIND ? seg + 2 * SEGSZ : E + 2 * SEGSZ;
    const float* XT = KIND ? (const float*)(p.ws + WS_DG) : (const float*)(p.ws + WS_AL);
    f32x16 S[4];
    if (wave < 4) __builtin_amdgcn_s_setprio(2);
    if (wave < 4) {
        if (grp) {
            const float* s0 = p.in[KIND ? 2 : 3] + (size_t)((l * 32 + bseq) * 4 + h) * 16384 + 32 * c + r;
#pragma unroll
            for (int i = 0; i < 4; ++i)
#pragma unroll
                for (int reg = 0; reg < 16; ++reg) S[i][reg] = s0[(32 * i + crow(reg, hh)) * 128];
        } else {
#pragma unroll
            for (int i = 0; i < 4; ++i) S[i] = zero16();
        }
    }
    u32x4 w_[KIND ? 8 : 10]; f32x4 wx_ = {0.f, 0.f, 0.f, 0.f};
    const int lt = tid - 256;
#define SCAN_ISSUE(gc_) do { \
        const size_t so_ = (size_t)(gc_) * 32 * 512 + h * 128; \
        _Pragma("unroll") for (int i_ = 0; i_ < 2; ++i_) { const int idx_ = lt + 256 * i_, row_ = idx_ >> 4, ch_ = idx_ & 15; const size_t o_ = so_ + (size_t)row_ * 512 + ch_ * 8; \
            w_[i_] = *(const u32x4*)(src0 + o_); w_[2 + i_] = *(const u32x4*)(src1 + o_); w_[4 + i_] = *(const u32x4*)(src2 + o_); w_[6 + i_] = *(const u32x4*)(src3 + o_); \
            if (!KIND) w_[(KIND ? 0 : 8) + i_] = *(const u32x4*)(src4 + o_); } \
        if (KIND) { if (lt < 32) wx_ = *(const f32x4*)(XT + (size_t)((gc_) * 4 + h) * 128 + lt * 4); } \
        else { if (lt == 0) wx_[0] = XT[(gc_) * 4 + h]; } \
    } while (0)
#define SCAN_WRITE(stage_) do { \
        unsigned char* st_ = shm + (stage_) * STG; \
        _Pragma("unroll") for (int i_ = 0; i_ < 2; ++i_) { const int idx_ = lt + 256 * i_, row_ = idx_ >> 4, ch_ = idx_ & 15; unsigned char* d_ = st_ + row_ * 256 + ch_ * 16; \
            *(u32x4*)d_ = w_[i_]; *(u32x4*)(d_ + 8192) = w_[2 + i_]; *(u32x4*)(d_ + 16384) = w_[4 + i_]; *(u32x4*)(d_ + 24576) = w_[6 + i_]; \
            if (!KIND) *(u32x4*)(d_ + 32768) = w_[(KIND ? 0 : 8) + i_]; } \
        if (KIND) { if (lt < 32) *(f32x4*)(st_ + 40960 + lt * 16) = wx_; } \
        else { if (lt == 0) *(float*)(st_ + 40960) = wx_[0]; } \
    } while (0)
    if (wave >= 4) { SCAN_ISSUE(gc0); SCAN_WRITE(0); if (nch > 1) SCAN_ISSUE(gc0 + 1); }
    __syncthreads();
    for (int ci = 0; ci < nch; ++ci) {
        const int gc = gc0 + ci, stage = ci & 1;
        if (wave >= 4) { if (ci + 1 < nch) SCAN_WRITE(stage ^ 1); if (ci + 2 < nch) SCAN_ISSUE(gc + 2); }
        else {
            const unsigned char* st = shm + stage * STG; const unsigned sa = ldsb + (unsigned)(stage * STG);
            const unsigned q_ = ((unsigned)lane & 15u) >> 2, pp_ = (unsigned)lane & 3u, blk_ = ((unsigned)lane >> 4) & 1u, h_ = (unsigned)lane >> 5;
            const unsigned lb_ = 2u * blk_ + (pp_ >> 1);
            const unsigned An0 = 256u * (8u * h_ + q_) + 16u * (lb_ ^ (2u * h_)) + 8u * (pp_ & 1u), An1 = 256u * (8u * h_ + 4u + q_) + 16u * (lb_ ^ (2u * h_ + 1u)) + 8u * (pp_ & 1u);
            const unsigned Ap0 = 256u * (4u * h_ + q_) + 16u * (lb_ ^ h_) + 8u * (pp_ & 1u), Ap1 = 256u * (8u + 4u * h_ + q_) + 16u * (lb_ ^ (2u + h_)) + 8u * (pp_ & 1u);
            const unsigned Cq0 = 64u * (0u ^ q_), Cq1 = 64u * (1u ^ q_), Cq2 = 64u * (2u ^ q_), Cq3 = 64u * (3u ^ q_), Cc = 64u * ((unsigned)c ^ q_);
            f32x16 o;
#pragma unroll
            for (int g = 0; g < 4; ++g) {
                const u32x2 w = *(const u32x2*)(st + 24576 + (((c * 4 + g) * 2 + hh) * 32 + r) * 8);
                o[4 * g] = __uint_as_float(w.x << 16); o[4 * g + 1] = __uint_as_float(w.x & 0xffff0000u); o[4 * g + 2] = __uint_as_float(w.y << 16); o[4 * g + 3] = __uint_as_float(w.y & 0xffff0000u);
            }
            f32x16 ws = zero16();
#pragma unroll
            for (int hf = 0; hf < (KIND ? 2 : 4); ++hf) {
                constexpr int GK = KIND ? 4 : 2;
                bf16x8 aq[GK], aw[GK];
#pragma unroll
                for (int k = 0; k < GK; ++k) {
                    aq[k] = *(const bf16x8*)(st + offb(r, 2 * (GK * hf + k) + hh));
                    if (!KIND) aw[k] = *(const bf16x8*)(st + 32768 + offb(r, 2 * (GK * hf + k) + hh));
                }
                __builtin_amdgcn_sched_barrier(0);
#pragma unroll
                for (int k = 0; k < GK; ++k) {
                    const int ss = GK * hf + k;
                    const bf16x8 b = pack_step(S[ss >> 1], ss & 1);
                    o = MFMA32(aq[k], b, o);
                    if (!KIND) ws = MFMA32(aw[k], b, ws);
                }
                __builtin_amdgcn_sched_barrier(0);
            }
            {
                bf16_t* od = odst + (size_t)gc * 32 * 512 + h * 128 + 32 * c + r;
#pragma unroll
                for (int reg = 0; reg < 16; ++reg) od[(size_t)crow(reg, hh) * 512] = cvt1(o[reg]);
            }
            if (KIND) {
#pragma unroll
                for (int i = 0; i < 4; ++i)
#pragma unroll
                    for (int g = 0; g < 4; ++g) {
                        const f32x4 d = *(const f32x4*)(st + 40960 + (32 * i + 8 * g + 4 * hh) * 4);
                        S[i][4 * g] *= d[0]; S[i][4 * g + 1] *= d[1]; S[i][4 * g + 2] *= d[2]; S[i][4 * g + 3] *= d[3];
                    }
#pragma unroll
                for (int ks = 0; ks < 2; ++ks) {
                    const unsigned k0_ = sa + 8192u + 4096u * ks + An0, k1_ = sa + 8192u + 4096u * ks + An1;
                    const Frag4 fa = tr_quad(k0_ + Cq0, k1_ + Cq0, k0_ + Cq1, k1_ + Cq1, k0_ + Cq2, k1_ + Cq2, k0_ + Cq3, k1_ + Cq3);
                    const bf16x8 b = tr_pair(sa + 16384u + 4096u * ks + An0 + Cc, sa + 16384u + 4096u * ks + An1 + Cc);
#pragma unroll
                    for (int i = 0; i < 4; ++i) S[i] = MFMA32(fa.f[i], b, S[i]);
                }
            } else {
                f32x16 uu;
#pragma unroll
                for (int g = 0; g < 4; ++g) {
                    const u32x2 w = *(const u32x2*)(st + 16384 + (((c * 4 + g) * 2 + hh) * 32 + r) * 8);
                    uu[4 * g] = __uint_as_float(w.x << 16) - ws[4 * g]; uu[4 * g + 1] = __uint_as_float(w.x & 0xffff0000u) - ws[4 * g + 1];
                    uu[4 * g + 2] = __uint_as_float(w.y << 16) - ws[4 * g + 2]; uu[4 * g + 3] = __uint_as_float(w.y & 0xffff0000u) - ws[4 * g + 3];
                }
                const float aL = *(const float*)(st + 40960);
#pragma unroll
                for (int i = 0; i < 4; ++i) S[i] *= aL;
#pragma unroll
                for (int ks = 0; ks < 2; ++ks) {
                    const unsigned k0_ = sa + 8192u + 4096u * ks + Ap0, k1_ = sa + 8192u + 4096u * ks + Ap1;
                    const Frag4 fa = tr_quad(k0_ + Cq0, k1_ + Cq0, k0_ + Cq1, k1_ + Cq1, k0_ + Cq2, k1_ + Cq2, k0_ + Cq3, k1_ + Cq3);
                    const bf16x8 b = pack_step(uu, ks);
#pragma unroll
                    for (int i = 0; i < 4; ++i) S[i] = MFMA32(fa.f[i], b, S[i]);
                }
            }
        }
        __syncthreads();
    }
    __builtin_amdgcn_s_setprio(0);
#undef SCAN_ISSUE
#undef SCAN_WRITE
    if (wave < 4) {
        float* so = p.out + (KIND ? (grp ? O_HGS : O_HGP) : (grp ? O_GDS : O_GDP)) + (size_t)((l * (grp ? 32 : 16) + bseq) * 4 + h) * 16384 + 32 * c + r;
#pragma unroll
        for (int i = 0; i < 4; ++i)
#pragma unroll
            for (int reg = 0; reg < 16; ++reg) so[(32 * i + crow(reg, hh)) * 128] = S[i][reg];
    }
    __syncthreads();
}

__device__ __forceinline__ void phase_scan(const Params& p, int l, unsigned char* shm) {
    const unsigned ldsb = (unsigned)(size_t)shm;
    const bool two_ = gridDim.x == 256;
    const int b_ = (int)blockIdx.x, G_ = (int)gridDim.x;
    const int nit = two_ ? (b_ < 128 ? 1 : 2) : (b_ < 384 ? (383 - b_) / G_ + 1 : 0);
    for (int it = 0; it < nit; ++it) {
        const int u = two_ ? (b_ < 128 ? b_ : b_ + 128 * it) : b_ + it * G_;
        int kind, grp, idx;
        if (u < 64) { kind = 0; grp = 0; idx = u; } else if (u < 128) { kind = 1; grp = 0; idx = u - 64; } else if (u < 256) { kind = 0; grp = 1; idx = u - 128; } else { kind = 1; grp = 1; idx = u - 256; }
        const int h = idx & 3, bseq = idx >> 2;
        if (kind == 0) scan_chain<0>(p, l, grp, bseq, h, shm, ldsb); else scan_chain<1>(p, l, grp, bseq, h, shm, ldsb);
    }
    if (l == 0 && gridDim.x == 256 && blockIdx.x >= 128) convert_tiles(p, (float*)shm, 1536, 8320, (int)blockIdx.x - 128, 128);
}

#define XB_TMO      128
#define XB_XCNT(j)  (256  + 64 * (j))
#define XB_XSUB(j)  (1280 + 64 * (j))
#define XB_XGEN(j)  (2304 + 64 * (j))
#define XB_TOP      3328
#define XB_TOPGEN   3392
#define XCD_BAR_WORDS 3456
#define XB_SPIN_CAP (1u << 18)

__device__ __forceinline__ unsigned xb_ld(unsigned* p)              { return __hip_atomic_load(p, __ATOMIC_RELAXED, __HIP_MEMORY_SCOPE_AGENT); }
__device__ __forceinline__ unsigned xb_add(unsigned* p, unsigned v) { return __hip_atomic_fetch_add(p, v, __ATOMIC_RELAXED, __HIP_MEMORY_SCOPE_AGENT); }
__device__ __forceinline__ unsigned xb_xcc_id() { return (unsigned)__builtin_amdgcn_s_getreg((3 << 11) | 20) & 0xFu; }
#define XB_SPIN(cond, bar) do { unsigned _sp = 0; while (cond) { __builtin_amdgcn_s_sleep(1); \
    if ((++_sp & 255u) == 0u) { if (xb_ld(&(bar)[XB_TMO])) break; if (_sp > XB_SPIN_CAP) { atomicAdd(&(bar)[XB_TMO], 1u); break; } } } } while (0)

struct XcdBarrier {
    unsigned* bar; unsigned x;
    volatile LAS unsigned* st;
};

__device__ __forceinline__ XcdBarrier xcd_barrier_post(unsigned* bar, volatile LAS unsigned* st) {
    XcdBarrier b; b.bar = bar; b.x = xb_xcc_id(); b.st = st;
    if (threadIdx.x == 0) (void)xb_add(&bar[XB_XCNT(b.x)], 1u);
    return b;
}
__device__ __forceinline__ void xcd_barrier_complete(unsigned* bar, unsigned x, unsigned& nloc, unsigned& nx) {
    const unsigned G = gridDim.x * gridDim.y * gridDim.z;
    unsigned sum, cnt, mine, sp = 0u;
    for (;;) {
        sum = 0u; cnt = 0u; mine = 0u;
#pragma unroll
        for (unsigned j = 0; j < 16; ++j) { const unsigned c = xb_ld(&bar[XB_XCNT(j)]); sum += c; cnt += (c > 0u) ? 1u : 0u; mine = (j == x) ? c : mine; }
        if (sum == G) break;
        __builtin_amdgcn_s_sleep(1);
        if ((++sp & 255u) == 0u) { if (xb_ld(&bar[XB_TMO])) break; if (sp > XB_SPIN_CAP) { atomicAdd(&bar[XB_TMO], 1u); break; } }
    }
    nloc = mine > 0u ? mine : 1u; nx = cnt > 0u ? cnt : 1u;
}

__device__ __forceinline__ void xcd_barrier(const XcdBarrier& b) {
    asm volatile("s_waitcnt vmcnt(0)" ::: "memory");
    __syncthreads();
    if (threadIdx.x == 0) {
        unsigned* bar = b.bar;
        __builtin_amdgcn_s_waitcnt(0);
        unsigned nloc = b.st[0], nx = b.st[1];
        if (nloc == 0u) { xcd_barrier_complete(bar, b.x, nloc, nx); b.st[0] = nloc; b.st[1] = nx; }
        const unsigned old = xb_add(&bar[XB_XSUB(b.x)], 1u);
        const unsigned gen = old / nloc;
        if (old + 1u == (gen + 1u) * nloc) {
            __builtin_amdgcn_fence(__ATOMIC_RELEASE, "agent");
            asm volatile("s_waitcnt vmcnt(0)" ::: "memory");
            const unsigned og = xb_add(&bar[XB_TOP], 1u);
            const unsigned tg = og / nx;
            if (og + 1u == (tg + 1u) * nx) xb_add(&bar[XB_TOPGEN], 1u);
            else XB_SPIN(xb_ld(&bar[XB_TOPGEN]) == tg, bar);
            __builtin_amdgcn_fence(__ATOMIC_ACQUIRE, "agent");
            xb_add(&bar[XB_XGEN(b.x)], 1u);
            asm volatile("s_waitcnt vmcnt(0)" ::: "memory");
        } else {
            XB_SPIN(xb_ld(&bar[XB_XGEN(b.x)]) == gen, bar);
            __builtin_amdgcn_fence(__ATOMIC_ACQUIRE, "agent");
            asm volatile("s_waitcnt vmcnt(0)" ::: "memory");
        }
    }
    __syncthreads();
}


template <int S_> __device__ __forceinline__ void layer_phase(const Params& p, const int l, unsigned char* shm) {
    float* L = (float*)shm; LAS unsigned char* lds = (LAS unsigned char*)shm;
    const bf16_t* wt = (const bf16_t*)(p.ws + WS_WT) + (size_t)l * WT_LAYER;
    bf16_t* seg = (bf16_t*)(p.ws + WS_SEG); bf16_t* H = (bf16_t*)(p.ws + WS_H); bf16_t* E = (bf16_t*)(p.ws + WS_E0);
    const float* MODl = (const float*)(p.ws + WS_MOD) + (size_t)l * 48 * 6144;
    float* X = p.out;
    pg8::StaticOrder S;
    if constexpr (S_ == 0) phase_norm<0>(p, l, L);
    if constexpr (S_ == 1) { const pg8::Gemm g{H, wt + WT_IN, MROWS, 4096, 1024, 1024}; S.init(MROWS, 4096, (int)gridDim.x, (int)blockIdx.x);
              const EpiB<4> E_{seg, 512, 512, SEGSZ, nullptr, (bf16_t*)(p.ws + WS_HALO)}; pg8::gemm_phase(lds, g, S, E_); }
    if constexpr (S_ == 2) phase_conv(p, l, L);
    if constexpr (S_ == 3) phase_prep(p, l, shm);
    if constexpr (S_ == 4) phase_scan(p, l, shm);
    if constexpr (S_ == 5) { phase_post(p, l); __syncthreads();
              const pg8::Gemm g{H, wt + WT_IN + (size_t)4096 * 1024, MROWS, 2048, 1024, 1024}; S.init(MROWS, 2048, (int)gridDim.x, (int)blockIdx.x);
              const EpiB<1> E_{seg, 1024, 1024, 4 * SEGSZ, nullptr, nullptr}; pg8::gemm_phase(lds, g, S, E_); }
    if constexpr (S_ == 6) { S.init(MROWS, 1024, (int)gridDim.x, (int)blockIdx.x);
              { const pg8::Gemm g{seg + 2 * SEGSZ, wt + WT_PA, MROWS, 1024, 512, 512}; const EpiB<2> E_{H, 1024, 0, 0, seg, nullptr}; pg8::gemm_phase(lds, g, S, E_); }
              { const pg8::Gemm g{E + 2 * SEGSZ, wt + WT_PB, MROWS, 1024, 512, 512}; const EpiB<3> E_{H, 1024, 0, 0, seg + 4 * SEGSZ, nullptr}; pg8::gemm_phase(lds, g, S, E_); } }
    if constexpr (S_ == 7) { { const pg8::Gemm g{H, wt + WT_OUT, NPROW, 1024, 1024, 1024}; S.init(NPROW, 1024, (int)gridDim.x, (int)blockIdx.x);
                const EpiResU E_{l == 0 ? p.in[0] : X, X, MODl + 2048}; pg8::gemm_phase(lds, g, S, E_); }
              { int ks_ = 512; asm volatile("" : "+s"(ks_)); const pg8::Gemm g{H, wt + WT_OUT, MROWS, 1024, ks_, 1024}; const SliceOrder SO{128, 4, 2, 512, 32, (int)gridDim.x, (int)blockIdx.x};
                const EpiRes2 E_{l == 0 ? p.in[1] : X + (size_t)NPROW * 1024, X, (float*)(p.ws + WS_E0) + (size_t)1024 * 1024, MODl + 2048}; pg8::gemm_phase(lds, g, SO, E_); } }
    if constexpr (S_ == 8) phase_norm<1>(p, l, L);
    if constexpr (S_ == 9) { const pg8::Gemm g{H, wt + WT_UP, MROWS, 5632, 1024, 1024}; S.init(MROWS, 5632, (int)gridDim.x, (int)blockIdx.x);
              const EpiUp E_{seg}; pg8::gemm_phase(lds, g, S, E_); }
    if constexpr (S_ == 10) { { const pg8::Gemm g{seg, wt + WT_DOWN, NPROW, 1024, 2816, 2816}; S.init(NPROW, 1024, (int)gridDim.x, (int)blockIdx.x);
                const EpiResU E_{X, X, MODl + 5120}; pg8::gemm_phase(lds, g, S, E_); }
              { int ks_ = 1408; asm volatile("" : "+s"(ks_)); const pg8::Gemm g{seg, wt + WT_DOWN, MROWS, 1024, ks_, 2816}; const SliceOrder SO{128, 4, 2, 1408, 32, (int)gridDim.x, (int)blockIdx.x};
                const EpiRes2 E_{X + (size_t)NPROW * 1024, X, (float*)(p.ws + WS_E0), MODl + 5120}; pg8::gemm_phase(lds, g, SO, E_); } }
}

#define IN_(k) (lo <= (k) && (k) < hi)
#define SEAM_(k) do { if (IN_(k) && IN_((k) + 1)) { if ((k) == 0) grid.sync(); else xcd_barrier(xbar); } } while (0)
#define LPH_(l, s) do { if (IN_(1 + 11 * (l) + (s))) layer_phase<s>(p, l, shm); SEAM_(1 + 11 * (l) + (s)); } while (0)
#define LAYER_(l) do { LPH_(l, 0); LPH_(l, 1); LPH_(l, 3); LPH_(l, 4); LPH_(l, 5); LPH_(l, 6); LPH_(l, 7); LPH_(l, 8); LPH_(l, 9); LPH_(l, 10); } while (0)

__global__ void __launch_bounds__(512, 2) mega(Params p) {
    extern __shared__ __attribute__((aligned(16))) unsigned char shm[];
    cg::grid_group grid = cg::this_grid();
    const int lo = p.ph0, hi = p.ph1;
    __shared__ uint4 xb_words;
    if (threadIdx.x == 0) xb_words = make_uint4(0u, 0u, 0u, 0u);
    __syncthreads();
    const XcdBarrier xbar = xcd_barrier_post((unsigned*)(p.ws + WS_BAR), (volatile LAS unsigned*)&xb_words);
    if (IN_(0)) phase_prologue(p, (float*)shm);
    SEAM_(0);
    LAYER_(0);
    LAYER_(1);
    if (IN_(23)) phase_norm<2>(p, 0, (float*)shm);
}

extern "C" void kernel_launch(void* const* d_in, const int* in_sizes, int n_in, void* d_out, int out_size, void* d_ws, size_t ws_size, hipStream_t stream) {
    constexpr int kLds = 131072;
    static int grid = 0;
    if (grid == 0) {
        if (n_in != 24 || ws_size < WS_END) { fprintf(stderr, "kernel_launch: unexpected n_in %d / ws %zu (need %zu)\n", n_in, ws_size, (size_t)WS_END); grid = -1; return; }
        int dev = 0, cus = 0, per_cu = 0;
        if (hipGetDevice(&dev) != hipSuccess || hipDeviceGetAttribute(&cus, hipDeviceAttributeMultiprocessorCount, dev) != hipSuccess) { grid = -1; return; }
        if (hipFuncSetAttribute((const void*)mega, hipFuncAttributeMaxDynamicSharedMemorySize, kLds) != hipSuccess) { fprintf(stderr, "kernel_launch: hipFuncSetAttribute failed\n"); grid = -1; return; }
        if (hipOccupancyMaxActiveBlocksPerMultiprocessor(&per_cu, (const void*)mega, 512, kLds) != hipSuccess || per_cu < 1) { fprintf(stderr, "kernel_launch: occupancy query says %d\n", per_cu); grid = -1; return; }
        grid = cus * per_cu;
    }
    if (grid < 0) return;
    if (hipMemsetAsync((unsigned char*)d_ws + WS_BAR, 0, 16384, stream) != hipSuccess) { fprintf(stderr, "kernel_launch: memset failed\n"); return; }
    Params p{};
    for (int i = 0; i < 24; ++i) p.in[i] = (const float*)d_in[i];
    p.out = (float*)d_out; p.ws = (unsigned char*)d_ws;
#if defined(MULTI_LAUNCH)
    for (int ph = 0; ph < 24; ++ph) { p.ph0 = ph; p.ph1 = ph + 1; hipLaunchKernelGGL(mega, dim3(grid), dim3(512), kLds, stream, p); }
#else
    p.ph0 = 0; p.ph1 = 24;
    void* args[] = {&p};
    const hipError_t e = hipLaunchCooperativeKernel((const void*)mega, dim3(grid), dim3(512), args, kLds, stream);
    if (e != hipSuccess) fprintf(stderr, "kernel_launch: cooperative launch failed: %s (grid %d)\n", hipGetErrorString(e), grid);
#endif
}
```
